# Optimizing an MI355X kernel written in HIP

```python
import math
import jax
import jax.numpy as jnp
from jax import lax
import numpy as np

D_MODEL = 1024
BATCH = 32
SEQ = 256
DEPTH = 4
DEC_BATCH = 8
DEC_SEQ = 2048
PAST_LEN = 512

GRID_W = 64
D_MIX = D_MODEL
GROUP_W = D_MIX // 4
N_MOD = 9
D_FF = 2816
EPS = 1e-6
ROPE_BASE = 10000.0
Q_BLOCK = 128
H_A = 4
DK_A = GROUP_W // H_A
DV_A = GROUP_W // H_A
A_WK = H_A * DK_A
A_WV = H_A * DV_A
GLA_CHUNK = 16
MAX_INPUT_KEY = 1.0 - 1e-6
H_B = 4
NOPE_B = 64
ROPE_B = 32
V_B = GROUP_W // H_B
Q_LORA = 256
KV_LORA = 128
W_C = GROUP_W
HY_ORDER = 2
HY_BANDS = 8
HY_EMB = 1 + 2 * HY_BANDS
HY_FH = 64
SHORT_K = 3
HY_MIN_DECAY = 3.07
HY_MAX_DECAY = 15.35
H_D = 4
DV_D = GROUP_W // H_D
DH_D = DV_D // 2
D_WQK = H_D * 2 * DH_D
D_WV = H_D * DV_D
IN_W = 3 * A_WK + 2 * A_WV + Q_LORA + KV_LORA + ROPE_B + 3 * W_C + 2 * D_WQK + D_WV

kernel_name = 'hybrid_dit_hgrn2_mla_hyena_diffattn_step'


def rmsnorm(x, g):
    xf = x.astype(jnp.float32)
    y = xf * lax.rsqrt(jnp.mean(xf * xf, axis=-1, keepdims=True) + EPS)
    return (y * g.astype(jnp.float32)).astype(x.dtype)


def swiglu(h, w_gu, w_down):
    a, u = jnp.split(h @ w_gu, 2, axis=-1)
    return (jax.nn.silu(a) * u) @ w_down


def axial_angles(n_tok, rot_dim):
    rows = n_tok // GRID_W
    r, col = jnp.meshgrid(jnp.arange(rows), jnp.arange(GRID_W), indexing='ij')
    n_f = rot_dim // 4
    inv = ROPE_BASE ** (-jnp.arange(n_f, dtype=jnp.float32) / n_f)
    ang_r = r.reshape(-1).astype(jnp.float32)[:, None] * inv
    ang_c = col.reshape(-1).astype(jnp.float32)[:, None] * inv
    return (ang_r, ang_c)


def rope_1d(x, ang):
    x1, x2 = jnp.split(x, 2, axis=-1)
    cos = jnp.cos(ang)[None, :, None, :].astype(x.dtype)
    sin = jnp.sin(ang)[None, :, None, :].astype(x.dtype)
    return jnp.concatenate([x1 * cos - x2 * sin, x1 * sin + x2 * cos], axis=-1)


def axial_rope(x, angs):
    xr, xc = jnp.split(x, 2, axis=-1)
    return jnp.concatenate([rope_1d(xr, angs[0]), rope_1d(xc, angs[1])], axis=-1)


def block_map(fn, q):
    b, lq = q.shape[:2]
    nb = lq // Q_BLOCK
    qb = jnp.moveaxis(q.reshape((b, nb, Q_BLOCK) + q.shape[2:]), 1, 0)
    out = lax.map(fn, qb)
    return jnp.moveaxis(out, 0, 1).reshape((b, lq) + out.shape[3:])


def gla_chunk(q, k, v, log_f, s0):
    b, n, h, dk = q.shape
    dv = v.shape[-1]
    nc = n // GLA_CHUNK
    r = lambda t: t.reshape(b, nc, GLA_CHUNK, h, t.shape[-1])
    q, k, v, g = r(q), r(k), r(v), r(log_f)
    cum = jnp.cumsum(g, axis=2)
    causal = jnp.tril(jnp.ones((GLA_CHUNK, GLA_CHUNK), dtype=bool))[None, None, :, :, None, None]
    diff = cum[:, :, :, None] - cum[:, :, None, :]
    decay = jnp.where(causal, jnp.exp(jnp.minimum(diff, 0.0)), 0.0)
    attn = jnp.einsum('bnthd,bnshd,bntshd->bnhts', q, k, decay)
    o_intra = jnp.einsum('bnhts,bnshv->bnthv', attn, v)
    last = cum[:, :, -1]
    upd = jnp.einsum('bnchk,bnchv->bnhkv', k * jnp.exp(last[:, :, None] - cum), v)

    def step(s, xs):
        a, u = xs
        return a[..., None] * s + u, s

    s_fin, s_prev = lax.scan(step, s0, (jnp.moveaxis(jnp.exp(last), 1, 0), jnp.moveaxis(upd, 1, 0)))
    o_inter = jnp.einsum('bnchk,nbhkv->bnchv', q * jnp.exp(cum), s_prev)
    return (o_intra + o_inter).reshape(b, n, h, dv), s_fin


def hgrn_forget(logit, lb):
    x = logit.astype(jnp.float32)
    lbf = lb.astype(jnp.float32).reshape(H_A, DK_A)
    k = jnp.minimum((1.0 - lbf) * jax.nn.sigmoid(-x), MAX_INPUT_KEY)
    log_f = jnp.log1p(-k)
    return log_f, k


def hgrn_mixer(pq, pi, pff, pfb, pog, lb_f, lb_b, onorm_g, s0):
    b, n, _ = pq.shape
    hv = lambda t, d: t.reshape(b, n, H_A, d)
    q = hv(jax.nn.silu(pq), DK_A).astype(jnp.float32) * DK_A ** -0.5
    v = hv(pi, DV_A).astype(jnp.float32)
    logf_f, k_f = hgrn_forget(hv(pff, DK_A), lb_f)
    logf_b, k_b = hgrn_forget(hv(pfb, DK_A), lb_b)
    s0 = s0.astype(jnp.float32)
    o_f, s_f = gla_chunk(q, k_f, v, logf_f, s0[:, 0])
    rev = lambda t: jnp.flip(t, axis=1)
    o_b, s_b = gla_chunk(rev(q), rev(k_b), rev(v), rev(logf_b), s0[:, 1])
    o = rmsnorm(o_f + rev(o_b), onorm_g) * jax.nn.silu(hv(pog, DV_A).astype(jnp.float32))
    return o.reshape(b, n, A_WV).astype(pq.dtype), jnp.stack([s_f, s_b], axis=1)


def mla_queries(c_q, w_uq, qn_g, angs):
    b, n, _ = c_q.shape
    q = rmsnorm((c_q @ w_uq).reshape(b, n, H_B, NOPE_B + ROPE_B), qn_g)
    if angs is not None:
        q = jnp.concatenate([q[..., :NOPE_B], axial_rope(q[..., NOPE_B:], angs)], axis=-1)
    return q


def mla_keys(c_kv, k_rope, w_ukv, kn_g, angs):
    b, n, _ = c_kv.shape
    kv = (c_kv @ w_ukv).reshape(b, n, H_B, NOPE_B + V_B)
    k = jnp.concatenate([kv[..., :NOPE_B], jnp.broadcast_to(k_rope[:, :, None, :], (b, n, H_B, ROPE_B))], axis=-1)
    k = rmsnorm(k, kn_g)
    if angs is not None:
        k = jnp.concatenate([k[..., :NOPE_B], axial_rope(k[..., NOPE_B:], angs)], axis=-1)
    return k, kv[..., NOPE_B:]


def mla_attend(q, k, v):
    scale = (NOPE_B + ROPE_B) ** -0.5

    def blk(qb):
        s = jnp.einsum('bqhd,bkhd->bhqk', qb, k).astype(jnp.float32) * scale
        p = jax.nn.softmax(s, axis=-1).astype(v.dtype)
        return jnp.einsum('bhqk,bkhd->bqhd', p, v)

    return block_map(blk, q)


def short_conv(x, w):
    pad = SHORT_K // 2
    n = x.shape[1]
    xp = jnp.pad(x, ((0, 0), (pad, pad), (0, 0)))
    return sum(xp[:, j:j + n] * w[j] for j in range(SHORT_K))


def hyena_filters(n, w1, b1, w2, b2, w3, log_decay):
    f32 = jnp.float32
    tn = jnp.arange(n, dtype=f32) / n
    ang = 2.0 * math.pi * tn[:, None] * jnp.arange(1, HY_BANDS + 1, dtype=f32)
    feats = jnp.concatenate([tn[:, None], jnp.cos(ang), jnp.sin(ang)], axis=-1)
    h = jnp.sin(feats @ w1.astype(f32) + b1.astype(f32))
    h = jnp.sin(h @ w2.astype(f32) + b2.astype(f32))
    h = (h @ w3.astype(f32)).reshape(n, 2, HY_ORDER, W_C)
    h = h * jnp.exp(-jnp.exp(log_decay.astype(f32))[None] * tn[:, None, None, None])
    h_f, h_b = h[:, 0], h[:, 1]
    filt = jnp.concatenate([h_f, jnp.zeros((1, HY_ORDER, W_C), f32), jnp.flip(h_b[1:], axis=0)], axis=0)
    return filt / (jnp.sum(jnp.abs(filt), axis=0, keepdims=True) + EPS)


def long_conv(u, filt, bias):
    n = u.shape[1]
    uf = jnp.fft.rfft(u, n=2 * n, axis=1)
    ff = jnp.fft.rfft(filt, n=2 * n, axis=0)
    y = jnp.fft.irfft(uf * ff[None], n=2 * n, axis=1)[:, :n]
    return y + u * bias.astype(jnp.float32)


def hyena_mixer(pv, px1, px2, w_short, w1, b1, w2, b2, w3, log_decay, bias):
    n = pv.shape[1]
    u = short_conv(jnp.concatenate([pv, px1, px2], axis=-1), w_short).astype(jnp.float32)
    v, x1, x2 = jnp.split(u, 3, axis=-1)
    filt = hyena_filters(n, w1, b1, w2, b2, w3, log_decay)
    z = x1 * long_conv(v, filt[:, 0], bias[0])
    z = x2 * long_conv(z, filt[:, 1], bias[1])
    return z.astype(pv.dtype)


def diff_heads(p, g, angs):
    b, n, _ = p.shape
    x = rmsnorm(p.reshape(b, n, H_D, 2, DH_D), g)
    if angs is not None:
        x = axial_rope(x.reshape(b, n, H_D * 2, DH_D), angs).reshape(b, n, H_D, 2, DH_D)
    return x


def diff_attend(q, k, v, lam, lam_init, sub_g):
    scale = DH_D ** -0.5

    def blk(qb):
        s = jnp.einsum('bqhmd,bkhmd->bmhqk', qb, k).astype(jnp.float32) * scale
        p = jax.nn.softmax(s, axis=-1)
        w = (p[:, 0] - lam * p[:, 1]).astype(v.dtype)
        return jnp.einsum('bhqk,bkhv->bqhv', w, v)

    return rmsnorm(block_map(blk, q), sub_g) * (1.0 - lam_init)


def mixing(h, l, P, lb, angs, ctx):
    b, n, _ = h.shape
    sizes = [A_WK, A_WV, A_WK, A_WK, A_WV, Q_LORA, KV_LORA, ROPE_B, W_C, W_C, W_C, D_WQK, D_WQK, D_WV]
    idx = np.cumsum(sizes)[:-1].tolist()
    (a_q, a_i, a_ff, a_fb, a_og, b_cq, b_ckv, b_kr,
     c_v, c_x1, c_x2, d_q, d_k, d_v) = jnp.split(h @ P['w_in'][l], idx, axis=-1)
    angs_b, angs_d = (None, None) if angs is None else angs
    s0 = jnp.zeros((b, 2, H_A, DK_A, DV_A), jnp.float32) if ctx is None else ctx['hgrn']
    o_a, s_hgrn = hgrn_mixer(a_q, a_i, a_ff, a_fb, a_og, lb[0, l], lb[1, l], P['hgrn_onorm'][l], s0)
    c_q = rmsnorm(b_cq, P['mla_q_norm'][l])
    c_kv = rmsnorm(b_ckv, P['mla_kv_norm'][l])
    q_b = mla_queries(c_q, P['mla_w_uq'][l], P['mla_qk_norm'][l, 0], angs_b)
    k_b, v_b = mla_keys(c_kv, b_kr, P['mla_w_ukv'][l], P['mla_qk_norm'][l, 1], angs_b)
    if ctx is not None:
        k_c, v_c = mla_keys(ctx['mla'][..., :KV_LORA], ctx['mla'][..., KV_LORA:], P['mla_w_ukv'][l], P['mla_qk_norm'][l, 1], None)
        k_b = jnp.concatenate([k_c, k_b], axis=1)
        v_b = jnp.concatenate([v_c, v_b], axis=1)
    o_b = mla_attend(q_b, k_b, v_b).reshape(b, n, H_B * V_B)
    o_c = hyena_mixer(c_v, c_x1, c_x2, P['hy_short'][l], P['hy_w1'][l], P['hy_b1'][l], P['hy_w2'][l],
                      P['hy_b2'][l], P['hy_w3'][l], P['hy_log_decay'][l], P['hy_bias'][l])
    lam_init = 0.8 - 0.6 * math.exp(-0.3 * l)
    dl = P['diff_lambda'][l].astype(jnp.float32)
    lam = jnp.exp(jnp.sum(dl[0] * dl[1])) - jnp.exp(jnp.sum(dl[2] * dl[3])) + lam_init
    q_d = diff_heads(d_q, P['diff_qk_norm'][l, 0], angs_d)
    k_d = diff_heads(d_k, P['diff_qk_norm'][l, 1], angs_d)
    v_d = d_v.reshape(b, n, H_D, DV_D)
    k_all, v_all = k_d, v_d
    if ctx is not None:
        k_all = jnp.concatenate([ctx['dk'], k_d], axis=1)
        v_all = jnp.concatenate([ctx['dv'], v_d], axis=1)
    o_d = diff_attend(q_d, k_all, v_all, lam, lam_init, P['diff_subln'][l]).reshape(b, n, D_WV)
    out = jnp.concatenate([o_a, o_b, o_c, o_d], axis=-1) @ P['w_out'][l]
    ctx_out = (jnp.concatenate([c_kv, b_kr], axis=-1), k_d, v_d, s_hgrn)
    return out, ctx_out


def layer(x, cvec, l, P, lb, angs, ctx):
    m = jax.nn.silu(cvec) @ P['w_mod'][l] + P['b_mod'][l]
    sh1, sc1, g1, sh2, sc2, g2, sh3, sc3, g3 = jnp.split(m, N_MOD, axis=-1)
    h = rmsnorm(x, P['norm_g'][l, 0]) * (1 + sc1) + sh1
    x = x + 0.5 * g1 * swiglu(h, P['ffn_w_gu'][l, 0], P['ffn_w_down'][l, 0])
    h = rmsnorm(x, P['norm_g'][l, 1]) * (1 + sc2) + sh2
    o, ctx_out = mixing(h, l, P, lb, angs, ctx)
    x = x + g2 * o
    h = rmsnorm(x, P['norm_g'][l, 2]) * (1 + sc3) + sh3
    x = x + 0.5 * g3 * swiglu(h, P['ffn_w_gu'][l, 1], P['ffn_w_down'][l, 1])
    return x, ctx_out


def setup_inputs(seed: int = 0) -> dict:
    key = jax.random.key(seed)
    ks = iter(jax.random.split(key, 40))
    f32 = jnp.float32
    nrm = lambda shape, s: s * jax.random.normal(next(ks), shape, f32)
    return {
        'x_prompt': nrm((BATCH, SEQ, D_MODEL), 1.0),
        'x_sample': nrm((DEC_BATCH, DEC_SEQ, D_MODEL), 1.0),
        'c': nrm((DEC_BATCH, D_MODEL), 1.0),
        'cache_mla': nrm((DEC_BATCH, DEPTH, PAST_LEN, KV_LORA + ROPE_B), 1.0),
        'cache_diff_k': nrm((DEC_BATCH, DEPTH, PAST_LEN, H_D, 2, DH_D), 1.0),
        'cache_diff_v': nrm((DEC_BATCH, DEPTH, PAST_LEN, H_D, DV_D), 1.0),
        'state_hgrn': nrm((DEC_BATCH, DEPTH, 2, H_A, DK_A, DV_A), 0.5),
        'c_ctx': nrm((D_MODEL,), 1.0),
        'w_mod': nrm((DEPTH, D_MODEL, N_MOD * D_MODEL), 0.5 * D_MODEL ** -0.5),
        'b_mod': nrm((DEPTH, N_MOD * D_MODEL), 0.02),
        'norm_g': 1.0 + nrm((DEPTH, 3, D_MODEL), 0.02),
        'ffn_w_gu': nrm((DEPTH, 2, D_MODEL, 2 * D_FF), D_MODEL ** -0.5),
        'ffn_w_down': nrm((DEPTH, 2, D_FF, D_MODEL), D_FF ** -0.5),
        'w_in': nrm((DEPTH, D_MODEL, IN_W), D_MODEL ** -0.5),
        'w_out': nrm((DEPTH, D_MIX, D_MODEL), D_MIX ** -0.5),
        'hgrn_lb_logits': nrm((2, DEPTH, A_WK), 0.1),
        'hgrn_onorm': 1.0 + nrm((DEPTH, DV_A), 0.02),
        'mla_q_norm': 1.0 + nrm((DEPTH, Q_LORA), 0.02),
        'mla_kv_norm': 1.0 + nrm((DEPTH, KV_LORA), 0.02),
        'mla_w_uq': nrm((DEPTH, Q_LORA, H_B * (NOPE_B + ROPE_B)), Q_LORA ** -0.5),
        'mla_w_ukv': nrm((DEPTH, KV_LORA, H_B * (NOPE_B + V_B)), KV_LORA ** -0.5),
        'mla_qk_norm': 1.0 + nrm((DEPTH, 2, NOPE_B + ROPE_B), 0.02),
        'hy_short': nrm((DEPTH, SHORT_K, 3 * W_C), SHORT_K ** -0.5),
        'hy_w1': nrm((DEPTH, HY_EMB, HY_FH), 1.0),
        'hy_b1': nrm((DEPTH, HY_FH), 0.1),
        'hy_w2': nrm((DEPTH, HY_FH, HY_FH), HY_FH ** -0.5),
        'hy_b2': nrm((DEPTH, HY_FH), 0.1),
        'hy_w3': nrm((DEPTH, HY_FH, 2 * HY_ORDER * W_C), HY_FH ** -0.5),
        'hy_log_decay': jnp.log(jnp.linspace(HY_MIN_DECAY, HY_MAX_DECAY, W_C, dtype=f32)) + nrm((DEPTH, 2, HY_ORDER, W_C), 0.05),
        'hy_bias': nrm((DEPTH, HY_ORDER, W_C), 0.1),
        'diff_qk_norm': 1.0 + nrm((DEPTH, 2, DH_D), 0.02),
        'diff_lambda': nrm((DEPTH, 4, DH_D), 0.1),
        'diff_subln': 1.0 + nrm((DEPTH, DV_D), 0.02),
    }


def reference(x_prompt, x_sample, c, cache_mla, cache_diff_k, cache_diff_v, state_hgrn, c_ctx,
              w_mod, b_mod, norm_g, ffn_w_gu, ffn_w_down, w_in, w_out, hgrn_lb_logits, hgrn_onorm,
              mla_q_norm, mla_kv_norm, mla_w_uq, mla_w_ukv, mla_qk_norm, hy_short, hy_w1, hy_b1,
              hy_w2, hy_b2, hy_w3, hy_log_decay, hy_bias, diff_qk_norm, diff_lambda, diff_subln):
    P = dict(w_mod=w_mod, b_mod=b_mod, norm_g=norm_g, ffn_w_gu=ffn_w_gu, ffn_w_down=ffn_w_down,
             w_in=w_in, w_out=w_out, hgrn_onorm=hgrn_onorm, mla_q_norm=mla_q_norm,
             mla_kv_norm=mla_kv_norm, mla_w_uq=mla_w_uq, mla_w_ukv=mla_w_ukv, mla_qk_norm=mla_qk_norm,
             hy_short=hy_short, hy_w1=hy_w1, hy_b1=hy_b1, hy_w2=hy_w2, hy_b2=hy_b2, hy_w3=hy_w3,
             hy_log_decay=hy_log_decay, hy_bias=hy_bias, diff_qk_norm=diff_qk_norm,
             diff_lambda=diff_lambda, diff_subln=diff_subln)
    lb_p = jax.nn.softmax(hgrn_lb_logits.astype(jnp.float32), axis=1)
    lb = jnp.cumsum(lb_p, axis=1) - lb_p[:, :1]
    n_lat = x_sample.shape[1]
    angs = (axial_angles(n_lat, ROPE_B), axial_angles(n_lat, DH_D))
    c_lat = c[:, None, :]
    x_p, x_s = x_prompt, x_sample
    mla_l, dk_l, dv_l, hg_l = [], [], [], []
    for l in range(DEPTH):
        x_p, (m_c, k_c, v_c, s_c) = layer(x_p, c_ctx, l, P, lb, None, None)
        mla_l.append(m_c.astype(x_prompt.dtype))
        dk_l.append(k_c.astype(x_prompt.dtype))
        dv_l.append(v_c.astype(x_prompt.dtype))
        hg_l.append(s_c.astype(x_prompt.dtype))
        ctx = dict(mla=cache_mla[:, l], dk=cache_diff_k[:, l], dv=cache_diff_v[:, l], hgrn=state_hgrn[:, l])
        x_s, _ = layer(x_s, c_lat, l, P, lb, angs, ctx)
    new_cache_mla = jnp.stack(mla_l, axis=1)
    new_cache_diff_k = jnp.stack(dk_l, axis=1)
    new_cache_diff_v = jnp.stack(dv_l, axis=1)
    new_state_hgrn = jnp.stack(hg_l, axis=1)
    return (x_p, x_s, new_cache_mla, new_cache_diff_k, new_cache_diff_v, new_state_hgrn)
```

```cpp
#include <hip/hip_runtime.h>
#include <hip/hip_cooperative_groups.h>
#include <cstdio>
namespace cg = cooperative_groups;

#ifndef MEGA
#define MEGA 0
#endif

typedef unsigned short u16;
using bf16x8 = __attribute__((ext_vector_type(8))) short;
using bf16x4 = __attribute__((ext_vector_type(4))) short;
using f32x4 = __attribute__((ext_vector_type(4))) float;
using f32x16 = __attribute__((ext_vector_type(16))) float;
using u32x4 = __attribute__((ext_vector_type(4))) unsigned;
#define DI __device__ __forceinline__

constexpr int NCTX = 8192, NLAT = 16384, MTOK = 24576, NKV = 28672;
constexpr int DFF = 2816, INWP = 3328;
constexpr float EPS = 1e-6f;
constexpr float LOG2E = 1.4426950408889634f;
constexpr float MAXK = 1.0f - 1e-6f;

constexpr size_t O_MLA = 25165824, O_DK = 30408704, O_DV = 38797312, O_HG = 47185920;

constexpr size_t WS_WGU = 0;
constexpr size_t WS_WDN = WS_WGU + (size_t)8 * 5632 * 1024 * 2;
constexpr size_t WS_WIN = WS_WDN + (size_t)8 * 1024 * 2816 * 2;
constexpr size_t WS_WOUT = WS_WIN + (size_t)4 * 3328 * 1024 * 2;
constexpr size_t WS_WUQ = WS_WOUT + (size_t)4 * 1024 * 1024 * 2;
constexpr size_t WS_WUKV = WS_WUQ + (size_t)4 * 384 * 256 * 2;
constexpr size_t WS_MOD = WS_WUKV + (size_t)4 * 512 * 128 * 2;
constexpr size_t WS_ROPE = WS_MOD + (size_t)4 * 9 * 9216 * 4;
constexpr size_t WS_FILT = WS_ROPE + (size_t)2048 * 32 * 4;
constexpr size_t FILT_L = 2359296;
constexpr size_t WS_HB = WS_FILT + (size_t)4 * FILT_L * 4;
constexpr size_t WS_ACT = WS_HB + (size_t)MTOK * 1024 * 2;
constexpr size_t WS_CQ = WS_ACT + (size_t)MTOK * 3328 * 2;
constexpr size_t WS_CKV = WS_CQ + (size_t)MTOK * 256 * 2;
constexpr size_t WS_QRAW = WS_CKV + (size_t)NKV * 128 * 2;
constexpr size_t WS_KVRAW = WS_QRAW + (size_t)MTOK * 256 * 4;
constexpr size_t WS_OF = WS_QRAW;
constexpr size_t WS_OBW = WS_KVRAW;
constexpr size_t WS_QM = WS_KVRAW + (size_t)NKV * 512 * 2;
constexpr size_t WS_KM = WS_QM + (size_t)MTOK * 384 * 2;
constexpr size_t WS_VTM = WS_KM + (size_t)NKV * 384 * 2;
constexpr size_t WS_QD = WS_VTM + (size_t)NKV * 256 * 2;
constexpr size_t WS_KD = WS_QD + (size_t)MTOK * 256 * 2;
constexpr size_t WS_VTD = WS_KD + (size_t)NKV * 256 * 2;
constexpr size_t WS_END = WS_VTD + (size_t)NKV * 256 * 2;

struct Params {
  const float* in[33];
  float* out;
  char* ws;
};
enum { I_XP = 0, I_XS, I_C, I_CMLA, I_CDK, I_CDV, I_SHG, I_CCTX, I_WMOD, I_BMOD, I_NORMG, I_WGU, I_WDN, I_WIN, I_WOUT,
       I_LB, I_ONORM, I_QNORM, I_KVNORM, I_WUQ, I_WUKV, I_QKNORM, I_HYSHORT, I_HYW1, I_HYB1, I_HYW2, I_HYB2, I_HYW3,
       I_HYDEC, I_HYBIAS, I_DQKNORM, I_DLAM, I_DSUBLN };

DI u16 f2bf(float x) { unsigned u = __float_as_uint(x); u += 0x7fffu + ((u >> 16) & 1u); return (u16)(u >> 16); }
DI float bf2f(u16 b) { return __uint_as_float(((unsigned)b) << 16); }
DI float bflo(unsigned u) { return __uint_as_float(u << 16); }
DI float bfhi(unsigned u) { return __uint_as_float(u & 0xffff0000u); }
DI unsigned pack2(float a, float b) { return (unsigned)f2bf(a) | ((unsigned)f2bf(b) << 16); }
DI float silu_f(float x) { return x / (1.f + __expf(-x)); }
DI float sigm_f(float x) { return 1.f / (1.f + __expf(-x)); }
DI float wave_sum(float v) { for (int o = 32; o; o >>= 1) v += __shfl_xor(v, o); return v; }

DI int seq_nk(int s) { return s < 32 ? 256 : 2560; }
DI int seq_nq(int s) { return s < 32 ? 256 : 2048; }
DI size_t seq_kvb(int s) { return s < 32 ? (size_t)s * 256 : (size_t)8192 + (size_t)(s - 32) * 2560; }
DI int seq_row0(int s) { return s < 32 ? s * 256 : 8192 + (s - 32) * 2048; }

DI void transpose_tile(const float* __restrict__ src, int ldsrc, u16* __restrict__ dst, int lddst, int n0, int k0,
                       int nvalid, int mode, float* tile) {
  const int tid = threadIdx.x;
  {
    const int nn = tid & 63, kq = tid >> 6;
    const int n = n0 + nn;
    int col = n;
    if (mode == 1) { int blk = n >> 5, w = n & 31; col = (w < 16) ? (blk * 16 + w) : (2816 + blk * 16 + (w - 16)); }
    const bool valid = n < nvalid;
    for (int i = 0; i < 16; ++i) {
      int k = i * 4 + kq;
      tile[k * 65 + nn] = valid ? src[(size_t)(k0 + k) * ldsrc + col] : 0.f;
    }
  }
  __syncthreads();
  {
    const int kk = tid & 63, nq = tid >> 6;
    for (int i = 0; i < 16; ++i) {
      int n2 = i * 4 + nq;
      dst[(size_t)(n0 + n2) * lddst + k0 + kk] = f2bf(tile[kk * 65 + n2]);
    }
  }
  __syncthreads();
}

DI void phase_wprep(const Params& p, char* smem) {
  float* tile = (float*)smem;
  const int total = 11264 + 5632 + 3328 + 1024 + 96 + 64;
  for (int id = blockIdx.x; id < total; id += gridDim.x) {
    int j = id;
    if (j < 11264) {
      int mat = j / 1408, rem = j % 1408, nt = rem / 16, kt = rem % 16;
      transpose_tile(p.in[I_WGU] + (size_t)mat * 1024 * 5632, 5632, (u16*)(p.ws + WS_WGU) + (size_t)mat * 5632 * 1024, 1024,
                     nt * 64, kt * 64, 5632, 1, tile);
      continue;
    }
    j -= 11264;
    if (j < 5632) {
      int mat = j / 704, rem = j % 704, nt = rem / 44, kt = rem % 44;
      transpose_tile(p.in[I_WDN] + (size_t)mat * 2816 * 1024, 1024, (u16*)(p.ws + WS_WDN) + (size_t)mat * 1024 * 2816, 2816,
                     nt * 64, kt * 64, 1024, 0, tile);
      continue;
    }
    j -= 5632;
    if (j < 3328) {
      int mat = j / 832, rem = j % 832, nt = rem / 16, kt = rem % 16;
      transpose_tile(p.in[I_WIN] + (size_t)mat * 1024 * 3232, 3232, (u16*)(p.ws + WS_WIN) + (size_t)mat * 3328 * 1024, 1024,
                     nt * 64, kt * 64, 3232, 0, tile);
      continue;
    }
    j -= 3328;
    if (j < 1024) {
      int mat = j / 256, rem = j % 256, nt = rem / 16, kt = rem % 16;
      transpose_tile(p.in[I_WOUT] + (size_t)mat * 1024 * 1024, 1024, (u16*)(p.ws + WS_WOUT) + (size_t)mat * 1024 * 1024, 1024,
                     nt * 64, kt * 64, 1024, 0, tile);
      continue;
    }
    j -= 1024;
    if (j < 96) {
      int mat = j / 24, rem = j % 24, nt = rem / 4, kt = rem % 4;
      transpose_tile(p.in[I_WUQ] + (size_t)mat * 256 * 384, 384, (u16*)(p.ws + WS_WUQ) + (size_t)mat * 384 * 256, 256,
                     nt * 64, kt * 64, 384, 0, tile);
      continue;
    }
    j -= 96;
    {
      int mat = j / 16, rem = j % 16, nt = rem / 2, kt = rem % 2;
      transpose_tile(p.in[I_WUKV] + (size_t)mat * 128 * 512, 512, (u16*)(p.ws + WS_WUKV) + (size_t)mat * 512 * 128, 128,
                     nt * 64, kt * 64, 512, 0, tile);
    }
  }
}

DI void phase_mod(const Params& p, char* smem) {
  float* s = (float*)smem;
  float* red = s + 9 * 1024;
  const int tid = threadIdx.x, lane = tid & 63, w = tid >> 6;
  float* MOD = (float*)(p.ws + WS_MOD);
  for (int id = blockIdx.x; id < 576; id += gridDim.x) {
    const int l = id / 144, n0 = (id % 144) * 64;
    __syncthreads();
    for (int i = tid; i < 9 * 1024; i += 256) {
      int c = i >> 10, k = i & 1023;
      float x = (c == 0) ? p.in[I_CCTX][k] : p.in[I_C][(c - 1) * 1024 + k];
      s[i] = silu_f(x);
    }
    __syncthreads();
    float acc[9];
#pragma unroll
    for (int c = 0; c < 9; ++c) acc[c] = 0.f;
    const float* wp = p.in[I_WMOD] + ((size_t)l * 1024 + w * 256) * 9216 + n0 + lane;
#pragma unroll 4
    for (int k = 0; k < 256; ++k) {
      float wv = wp[(size_t)k * 9216];
#pragma unroll
      for (int c = 0; c < 9; ++c) acc[c] += s[c * 1024 + w * 256 + k] * wv;
    }
#pragma unroll
    for (int c = 0; c < 9; ++c) red[(w * 9 + c) * 64 + lane] = acc[c];
    __syncthreads();
    for (int i = tid; i < 576; i += 256) {
      int c = i >> 6, ln = i & 63;
      float v = red[(0 * 9 + c) * 64 + ln] + red[(1 * 9 + c) * 64 + ln] + red[(2 * 9 + c) * 64 + ln] + red[(3 * 9 + c) * 64 + ln];
      MOD[((size_t)l * 9 + c) * 9216 + n0 + ln] = v + p.in[I_BMOD][l * 9216 + n0 + ln];
    }
  }
}

DI void phase_rope(const Params& p) {
  float* R = (float*)(p.ws + WS_ROPE);
  for (int i = blockIdx.x * 256 + threadIdx.x; i < 2048 * 16; i += gridDim.x * 256) {
    int t = i >> 4, k = i & 15;
    float pos = (k < 8) ? (float)(t >> 6) : (float)(t & 63);
    float inv = powf(10000.f, -(float)(k & 7) / 8.f);
    float ang = pos * inv;
    R[t * 32 + k] = cosf(ang);
    R[t * 32 + 16 + k] = sinf(ang);
  }
}

DI float* filt_ptr(const Params& p, int l, int kind) { return (float*)(p.ws + WS_FILT) + (size_t)l * FILT_L + (kind ? 262144 : 0); }

DI void phase_filt(const Params& p, char* smem) {
  float* h1 = (float*)smem;
  float* h2 = h1 + 1024;
  const int tid = threadIdx.x, unit = tid & 63, tq = tid >> 6;
  for (int id = blockIdx.x; id < 576; id += gridDim.x) {
    const int l = id / 144, rem = id % 144;
    const int kind = rem < 16 ? 0 : 1, tb = rem < 16 ? rem : rem - 16;
    const int n = kind ? 2048 : 256, tau0 = tb * 16;
    const float* w1 = p.in[I_HYW1] + (size_t)l * 17 * 64;
    const float* w2 = p.in[I_HYW2] + (size_t)l * 64 * 64;
    const float* w3 = p.in[I_HYW3] + (size_t)l * 64 * 1024;
    __syncthreads();
    for (int j = 0; j < 4; ++j) {
      int ti = tq + 4 * j;
      float tn = (float)(tau0 + ti) / (float)n;
      float a = 6.283185307179586f * tn;
      float sacc = p.in[I_HYB1][l * 64 + unit] + tn * w1[unit];
      for (int k = 1; k <= 8; ++k) {
        float ak = a * (float)k;
        sacc += cosf(ak) * w1[k * 64 + unit] + sinf(ak) * w1[(8 + k) * 64 + unit];
      }
      h1[ti * 64 + unit] = sinf(sacc);
    }
    __syncthreads();
    for (int j = 0; j < 4; ++j) {
      int ti = tq + 4 * j;
      float sacc = p.in[I_HYB2][l * 64 + unit];
      for (int i = 0; i < 64; ++i) sacc += h1[ti * 64 + i] * w2[i * 64 + unit];
      h2[ti * 64 + unit] = sinf(sacc);
    }
    __syncthreads();
    float* FB = filt_ptr(p, l, kind);
    for (int cc = 0; cc < 4; ++cc) {
      const int col = tid + 256 * cc;
      float wc[64];
#pragma unroll
      for (int i = 0; i < 64; ++i) wc[i] = w3[i * 1024 + col];
      const float dec = expf(p.in[I_HYDEC][l * 1024 + col]);
      const int dir = col >> 9, oc = col & 511;
      float* F = FB + (size_t)oc * 2 * n;
      for (int ti = 0; ti < 16; ++ti) {
        float v = 0.f;
#pragma unroll
        for (int i = 0; i < 64; ++i) v += h2[ti * 64 + i] * wc[i];
        const int tau = tau0 + ti;
        v *= expf(-dec * ((float)tau / (float)n));
        if (dir == 0) F[n + tau] = v;
        else if (tau >= 1) F[n - tau] = v;
        else F[0] = 0.f;
      }
    }
  }
}

DI void phase_filtnorm(const Params& p) {
  const int lane = threadIdx.x & 63;
  const int gw = blockIdx.x * 4 + (threadIdx.x >> 6), nw = gridDim.x * 4;
  for (int id = gw; id < 4096; id += nw) {
    const int l = id >> 10, rem = id & 1023, kind = rem >> 9, oc = rem & 511;
    const int n2 = kind ? 4096 : 512;
    float* F = filt_ptr(p, l, kind) + (size_t)oc * n2;
    float s = 0.f;
    for (int i = lane; i < n2; i += 64) s += fabsf(F[i]);
    s = wave_sum(s);
    const float sc = 1.f / (s + EPS);
    for (int i = lane; i < n2; i += 64) F[i] *= sc;
  }
}

DI void phase_copyx(const Params& p) {
  float4* dst = (float4*)p.out;
  const float4* a = (const float4*)p.in[I_XP];
  const float4* b = (const float4*)p.in[I_XS];
  const size_t na = (size_t)NCTX * 256, nb = (size_t)NLAT * 256;
  for (size_t i = (size_t)blockIdx.x * 256 + threadIdx.x; i < na + nb; i += (size_t)gridDim.x * 256)
    dst[i] = i < na ? a[i] : b[i - na];
}

DI void phase_adaln(const Params& p, int l, int which) {
  const int lane = threadIdx.x & 63;
  const int gw = blockIdx.x * 4 + (threadIdx.x >> 6), nw = gridDim.x * 4;
  const float* MOD = (const float*)(p.ws + WS_MOD);
  u16* HB = (u16*)(p.ws + WS_HB);
  const float* g = p.in[I_NORMG] + (size_t)(l * 3 + which) * 1024;
  for (int r = gw; r < MTOK; r += nw) {
    const int cond = r < NCTX ? 0 : 1 + ((r - NCTX) >> 11);
    const float* sh = MOD + ((size_t)l * 9 + cond) * 9216 + which * 3072;
    const float* sc = sh + 1024;
    const float* x = p.out + (size_t)r * 1024;
    float4 v[4];
    float ss = 0.f;
#pragma unroll
    for (int i = 0; i < 4; ++i) {
      v[i] = *(const float4*)(x + i * 256 + lane * 4);
      ss += v[i].x * v[i].x + v[i].y * v[i].y + v[i].z * v[i].z + v[i].w * v[i].w;
    }
    ss = wave_sum(ss);
    const float rstd = rsqrtf(ss * (1.f / 1024.f) + EPS);
#pragma unroll
    for (int i = 0; i < 4; ++i) {
      const int c = i * 256 + lane * 4;
      float4 gg = *(const float4*)(g + c), s4 = *(const float4*)(sc + c), h4 = *(const float4*)(sh + c);
      float y0 = v[i].x * rstd * gg.x * (1.f + s4.x) + h4.x;
      float y1 = v[i].y * rstd * gg.y * (1.f + s4.y) + h4.y;
      float y2 = v[i].z * rstd * gg.z * (1.f + s4.z) + h4.z;
      float y3 = v[i].w * rstd * gg.w * (1.f + s4.w) + h4.w;
      uint2 o; o.x = pack2(y0, y1); o.y = pack2(y2, y3);
      *(uint2*)(HB + (size_t)r * 1024 + c) = o;
    }
  }
}

struct Epi { u16* Cb; int ldc; float* X; const float* gvec; float coef; };
enum { EPI_GU = 0, EPI_RESID = 1, EPI_BF16 = 2 };

template <int EPI>
DI void gemm_tile(const u16* __restrict__ A, int lda, const u16* __restrict__ Bt, int ldb, int K, int m0, int n0,
                  const Epi& e, char* smem) {
  const int tid = threadIdx.x, lane = tid & 63, w = tid >> 6, wm = w >> 1, wn = w & 1, fr = lane & 15, fq = lane >> 4;
  char* As = smem;
  char* Bs = smem + 16384;
  f32x4 acc[4][4];
#pragma unroll
  for (int i = 0; i < 4; ++i)
#pragma unroll
    for (int j = 0; j < 4; ++j) acc[i][j] = f32x4{0.f, 0.f, 0.f, 0.f};
  u32x4 ra[4], rb[4];
  const int lrow = tid >> 3, lch = tid & 7;
  const u16* Ap = A + (size_t)(m0 + lrow) * lda + lch * 8;
  const u16* Bp = Bt + (size_t)(n0 + lrow) * ldb + lch * 8;
#pragma unroll
  for (int i = 0; i < 4; ++i) {
    ra[i] = *(const u32x4*)(Ap + (size_t)(32 * i) * lda);
    rb[i] = *(const u32x4*)(Bp + (size_t)(32 * i) * ldb);
  }
  const int nk = K >> 6;
  for (int kt = 0; kt < nk; ++kt) {
    __syncthreads();
#pragma unroll
    for (int i = 0; i < 4; ++i) {
      const int row = lrow + 32 * i;
      const int off = row * 128 + ((lch ^ ((row >> 1) & 7)) << 4);
      *(u32x4*)(As + off) = ra[i];
      *(u32x4*)(Bs + off) = rb[i];
    }
    __syncthreads();
    if (kt + 1 < nk) {
      const int k0 = (kt + 1) << 6;
#pragma unroll
      for (int i = 0; i < 4; ++i) {
        ra[i] = *(const u32x4*)(Ap + (size_t)(32 * i) * lda + k0);
        rb[i] = *(const u32x4*)(Bp + (size_t)(32 * i) * ldb + k0);
      }
    }
#pragma unroll
    for (int kk = 0; kk < 2; ++kk) {
      bf16x8 af[4], bfr[4];
#pragma unroll
      for (int mi = 0; mi < 4; ++mi) {
        const int row = wm * 64 + mi * 16 + fr;
        af[mi] = *(const bf16x8*)(As + row * 128 + (((kk * 4 + fq) ^ ((row >> 1) & 7)) << 4));
      }
#pragma unroll
      for (int ni = 0; ni < 4; ++ni) {
        const int row = wn * 64 + ni * 16 + fr;
        bfr[ni] = *(const bf16x8*)(Bs + row * 128 + (((kk * 4 + fq) ^ ((row >> 1) & 7)) << 4));
      }
#pragma unroll
      for (int mi = 0; mi < 4; ++mi)
#pragma unroll
        for (int ni = 0; ni < 4; ++ni)
          acc[mi][ni] = __builtin_amdgcn_mfma_f32_16x16x32_bf16(af[mi], bfr[ni], acc[mi][ni], 0, 0, 0);
    }
  }
  if (EPI == EPI_GU) {
#pragma unroll
    for (int mi = 0; mi < 4; ++mi)
#pragma unroll
      for (int pp = 0; pp < 2; ++pp)
#pragma unroll
        for (int j = 0; j < 4; ++j) {
          const int grow = m0 + wm * 64 + mi * 16 + fq * 4 + j;
          const int ocol = ((n0 + wn * 64) >> 1) + pp * 16 + fr;
          const float a = acc[mi][2 * pp][j], u = acc[mi][2 * pp + 1][j];
          e.Cb[(size_t)grow * e.ldc + ocol] = f2bf(silu_f(a) * u);
        }
  } else if (EPI == EPI_RESID) {
    const int cond = m0 < NCTX ? 0 : 1 + ((m0 - NCTX) >> 11);
    const float* gv = e.gvec + (size_t)cond * 9216;
#pragma unroll
    for (int mi = 0; mi < 4; ++mi)
#pragma unroll
      for (int ni = 0; ni < 4; ++ni) {
        const int gcol = n0 + wn * 64 + ni * 16 + fr;
        const float gg = e.coef * gv[gcol];
#pragma unroll
        for (int j = 0; j < 4; ++j) {
          const int grow = m0 + wm * 64 + mi * 16 + fq * 4 + j;
          float* xp = e.X + (size_t)grow * 1024 + gcol;
          *xp = *xp + gg * acc[mi][ni][j];
        }
      }
  } else {
#pragma unroll
    for (int mi = 0; mi < 4; ++mi)
#pragma unroll
      for (int ni = 0; ni < 4; ++ni)
#pragma unroll
        for (int j = 0; j < 4; ++j) {
          const int grow = m0 + wm * 64 + mi * 16 + fq * 4 + j;
          const int gcol = n0 + wn * 64 + ni * 16 + fr;
          e.Cb[(size_t)grow * e.ldc + gcol] = f2bf(acc[mi][ni][j]);
        }
  }
}

template <int EPI>
DI void phase_gemm(const u16* A, int lda, const u16* Bt, int ldb, int Mrows, int N, int K, const Epi& e, char* smem) {
  const int nN = N >> 7, total = (Mrows >> 7) * nN;
  for (int id = blockIdx.x; id < total; id += gridDim.x) {
    const int mt = id / nN, nt = id % nN;
    gemm_tile<EPI>(A, lda, Bt, ldb, K, mt * 128, nt * 128, e, smem);
  }
}

DI void phase_gsmall(const Params& p, int l, char* smem) {
  const int t1 = 192 * 3, t2 = 224 * 4;
  for (int id = blockIdx.x; id < t1 + t2; id += gridDim.x) {
    if (id < t1) {
      Epi e{(u16*)(p.ws + WS_QRAW), 384, nullptr, nullptr, 0.f};
      gemm_tile<EPI_BF16>((const u16*)(p.ws + WS_CQ), 256, (const u16*)(p.ws + WS_WUQ) + (size_t)l * 384 * 256, 256, 256,
                          (id / 3) * 128, (id % 3) * 128, e, smem);
    } else {
      const int j = id - t1;
      Epi e{(u16*)(p.ws + WS_KVRAW), 512, nullptr, nullptr, 0.f};
      gemm_tile<EPI_BF16>((const u16*)(p.ws + WS_CKV), 128, (const u16*)(p.ws + WS_WUKV) + (size_t)l * 512 * 128, 128, 128,
                          (j / 4) * 128, (j % 4) * 128, e, smem);
    }
  }
}

DI void phase_prep1(const Params& p, int l) {
  const int lane = threadIdx.x & 63;
  const int gw = blockIdx.x * 4 + (threadIdx.x >> 6), nw = gridDim.x * 4;
  const u16* PROJ = (const u16*)(p.ws + WS_ACT);
  u16* CQ = (u16*)(p.ws + WS_CQ);
  u16* CKV = (u16*)(p.ws + WS_CKV);
  u16* QD = (u16*)(p.ws + WS_QD);
  u16* KD = (u16*)(p.ws + WS_KD);
  u16* VTD = (u16*)(p.ws + WS_VTD);
  const float* ROPE = (const float*)(p.ws + WS_ROPE);
  const float scaleq = 0.17677669529663687f * LOG2E;
  for (int it = gw; it < MTOK + 4096; it += nw) {
    if (it < MTOK) {
      const int r = it;
      const bool ctx = r < NCTX;
      int b, t;
      if (ctx) { b = r >> 8; t = r & 255; } else { int rl = r - NCTX; b = rl >> 11; t = rl & 2047; }
      const int seq = ctx ? b : 32 + b, nk = ctx ? 256 : 2560, key = ctx ? t : 512 + t;
      const size_t kvb = seq_kvb(seq);
      const u16* pr = PROJ + (size_t)r * INWP;
      const size_t orow = ((size_t)b * 4 + l) * 256 + t;
      {
        uint2 raw = *(const uint2*)(pr + 1280 + lane * 4);
        float v0 = bflo(raw.x), v1 = bfhi(raw.x), v2 = bflo(raw.y), v3 = bfhi(raw.y);
        float ss = wave_sum(v0 * v0 + v1 * v1 + v2 * v2 + v3 * v3);
        float rstd = rsqrtf(ss * (1.f / 256.f) + EPS);
        const float* g = p.in[I_QNORM] + l * 256 + lane * 4;
        uint2 o; o.x = pack2(v0 * rstd * g[0], v1 * rstd * g[1]); o.y = pack2(v2 * rstd * g[2], v3 * rstd * g[3]);
        *(uint2*)(CQ + (size_t)r * 256 + lane * 4) = o;
      }
      {
        unsigned raw = *(const unsigned*)(pr + 1536 + lane * 2);
        float v0 = bflo(raw), v1 = bfhi(raw);
        float ss = wave_sum(v0 * v0 + v1 * v1);
        float rstd = rsqrtf(ss * (1.f / 128.f) + EPS);
        const float* g = p.in[I_KVNORM] + l * 128 + lane * 2;
        float c0 = v0 * rstd * g[0], c1 = v1 * rstd * g[1];
        *(unsigned*)(CKV + (kvb + key) * 128 + lane * 2) = pack2(c0, c1);
        if (ctx) {
          float* om = p.out + O_MLA + orow * 160;
          *(float2*)(om + lane * 2) = float2{c0, c1};
          if (lane < 32) om[128 + lane] = bf2f(pr[1664 + lane]);
        }
      }
#pragma unroll
      for (int which = 0; which < 2; ++which) {
        uint2 raw = *(const uint2*)(pr + (which ? 2720 : 2464) + lane * 4);
        float y[4] = {bflo(raw.x), bfhi(raw.x), bflo(raw.y), bfhi(raw.y)};
        float ss = y[0] * y[0] + y[1] * y[1] + y[2] * y[2] + y[3] * y[3];
        ss += __shfl_xor(ss, 1); ss += __shfl_xor(ss, 2); ss += __shfl_xor(ss, 4);
        const float rstd = rsqrtf(ss * (1.f / 32.f) + EPS);
        const int d0 = (lane & 7) * 4;
        const float* g = p.in[I_DQKNORM] + (l * 2 + which) * 32 + d0;
#pragma unroll
        for (int i = 0; i < 4; ++i) y[i] = y[i] * rstd * g[i];
        if (which == 1 && ctx) *(float4*)(p.out + O_DK + orow * 256 + lane * 4) = float4{y[0], y[1], y[2], y[3]};
        if (!ctx) {
#pragma unroll
          for (int i = 0; i < 4; ++i) {
            float pv = __shfl_xor(y[i], 2);
            const int ti = ((lane & 4) ? 8 : 0) + (lane & 1) * 4 + i;
            const float cs = ROPE[t * 32 + ti], sn = ROPE[t * 32 + 16 + ti];
            y[i] = (lane & 2) ? (pv * sn + y[i] * cs) : (y[i] * cs - pv * sn);
          }
        }
        if (which == 0) {
          uint2 o; o.x = pack2(y[0] * scaleq, y[1] * scaleq); o.y = pack2(y[2] * scaleq, y[3] * scaleq);
          *(uint2*)(QD + (size_t)r * 256 + lane * 4) = o;
        } else {
          uint2 o; o.x = pack2(y[0], y[1]); o.y = pack2(y[2], y[3]);
          *(uint2*)(KD + kvb * 256 + ((size_t)(lane >> 3) * nk + key) * 32 + d0) = o;
        }
      }
      {
        uint2 raw = *(const uint2*)(pr + 2976 + lane * 4);
        if (ctx) *(float4*)(p.out + O_DV + orow * 256 + lane * 4) = float4{bflo(raw.x), bfhi(raw.x), bflo(raw.y), bfhi(raw.y)};
        u16* vt = VTD + kvb * 256 + (size_t)(lane * 4) * nk + key;
        vt[0] = (u16)(raw.x & 0xffff); vt[nk] = (u16)(raw.x >> 16);
        vt[2 * (size_t)nk] = (u16)(raw.y & 0xffff); vt[3 * (size_t)nk] = (u16)(raw.y >> 16);
      }
    } else {
      const int j = it - MTOK, b = j >> 9, tc = j & 511;
      const size_t kvb = seq_kvb(32 + b);
      const int nk = 2560;
      const size_t crow = ((size_t)b * 4 + l) * 512 + tc;
      {
        float2 v = *(const float2*)(p.in[I_CMLA] + crow * 160 + lane * 2);
        *(unsigned*)(CKV + (kvb + tc) * 128 + lane * 2) = pack2(v.x, v.y);
      }
      {
        float4 v = *(const float4*)(p.in[I_CDK] + crow * 256 + lane * 4);
        uint2 o; o.x = pack2(v.x, v.y); o.y = pack2(v.z, v.w);
        *(uint2*)(KD + kvb * 256 + ((size_t)(lane >> 3) * nk + tc) * 32 + (lane & 7) * 4) = o;
      }
      {
        float4 v = *(const float4*)(p.in[I_CDV] + crow * 256 + lane * 4);
        u16* vt = VTD + kvb * 256 + (size_t)(lane * 4) * nk + tc;
        vt[0] = f2bf(v.x); vt[nk] = f2bf(v.y); vt[2 * (size_t)nk] = f2bf(v.z); vt[3 * (size_t)nk] = f2bf(v.w);
      }
    }
  }
}

DI void phase_prep2(const Params& p, int l) {
  const int lane = threadIdx.x & 63, hh = lane >> 4, e = lane & 15;
  const int gw = blockIdx.x * 4 + (threadIdx.x >> 6), nw = gridDim.x * 4;
  const u16* PROJ = (const u16*)(p.ws + WS_ACT);
  const u16* QRAW = (const u16*)(p.ws + WS_QRAW);
  const u16* KVRAW = (const u16*)(p.ws + WS_KVRAW);
  u16* QM = (u16*)(p.ws + WS_QM);
  u16* KM = (u16*)(p.ws + WS_KM);
  u16* VTM = (u16*)(p.ws + WS_VTM);
  const float* ROPE = (const float*)(p.ws + WS_ROPE);
  const float scalem = 0.10206207261596577f * LOG2E;
  for (int it = gw; it < MTOK + NKV; it += nw) {
    if (it < MTOK) {
      const int r = it;
      const bool ctx = r < NCTX;
      const int t = ctx ? (r & 255) : ((r - NCTX) & 2047);
      const u16* src = QRAW + (size_t)r * 384 + hh * 96;
      float y[6];
      float ss = 0.f;
#pragma unroll
      for (int i = 0; i < 6; ++i) { y[i] = bf2f(src[e + 16 * i]); ss += y[i] * y[i]; }
      ss += __shfl_xor(ss, 1); ss += __shfl_xor(ss, 2); ss += __shfl_xor(ss, 4); ss += __shfl_xor(ss, 8);
      const float rstd = rsqrtf(ss * (1.f / 96.f) + EPS);
      const float* g = p.in[I_QKNORM] + (l * 2 + 0) * 96;
#pragma unroll
      for (int i = 0; i < 6; ++i) y[i] = y[i] * rstd * g[e + 16 * i];
      if (!ctx) {
#pragma unroll
        for (int i = 4; i < 6; ++i) {
          float pv = __shfl_xor(y[i], 8);
          const int ti = (i == 5 ? 8 : 0) + (e & 7);
          const float cs = ROPE[t * 32 + ti], sn = ROPE[t * 32 + 16 + ti];
          y[i] = (e & 8) ? (pv * sn + y[i] * cs) : (y[i] * cs - pv * sn);
        }
      }
      u16* dst = QM + (size_t)r * 384 + hh * 96;
#pragma unroll
      for (int i = 0; i < 6; ++i) dst[e + 16 * i] = f2bf(y[i] * scalem);
    } else {
      const int kvrow = it - MTOK;
      int seq, key, t = 0;
      bool rope = false;
      const u16* kr_bf = nullptr;
      const float* kr_f = nullptr;
      if (kvrow < NCTX) {
        seq = kvrow >> 8; key = kvrow & 255;
        kr_bf = PROJ + (size_t)kvrow * INWP + 1664;
      } else {
        const int rl = kvrow - NCTX, b = rl / 2560;
        key = rl - b * 2560; seq = 32 + b;
        if (key < 512) kr_f = p.in[I_CMLA] + (((size_t)b * 4 + l) * 512 + key) * 160 + 128;
        else { t = key - 512; rope = true; kr_bf = PROJ + (size_t)(NCTX + b * 2048 + t) * INWP + 1664; }
      }
      const int nk = seq_nk(seq);
      const size_t kvb = seq_kvb(seq);
      const u16* src = KVRAW + (size_t)kvrow * 512 + hh * 128;
      float y[6];
      float ss = 0.f;
#pragma unroll
      for (int i = 0; i < 4; ++i) y[i] = bf2f(src[e + 16 * i]);
#pragma unroll
      for (int i = 4; i < 6; ++i) y[i] = kr_bf ? bf2f(kr_bf[e + 16 * (i - 4)]) : kr_f[e + 16 * (i - 4)];
#pragma unroll
      for (int i = 0; i < 6; ++i) ss += y[i] * y[i];
      ss += __shfl_xor(ss, 1); ss += __shfl_xor(ss, 2); ss += __shfl_xor(ss, 4); ss += __shfl_xor(ss, 8);
      const float rstd = rsqrtf(ss * (1.f / 96.f) + EPS);
      const float* g = p.in[I_QKNORM] + (l * 2 + 1) * 96;
#pragma unroll
      for (int i = 0; i < 6; ++i) y[i] = y[i] * rstd * g[e + 16 * i];
      if (rope) {
#pragma unroll
        for (int i = 4; i < 6; ++i) {
          float pv = __shfl_xor(y[i], 8);
          const int ti = (i == 5 ? 8 : 0) + (e & 7);
          const float cs = ROPE[t * 32 + ti], sn = ROPE[t * 32 + 16 + ti];
          y[i] = (e & 8) ? (pv * sn + y[i] * cs) : (y[i] * cs - pv * sn);
        }
      }
      u16* dst = KM + kvb * 384 + ((size_t)hh * nk + key) * 96;
#pragma unroll
      for (int i = 0; i < 6; ++i) dst[e + 16 * i] = f2bf(y[i]);
      u16* vt = VTM + kvb * 256 + (size_t)(hh * 64) * nk + key;
#pragma unroll
      for (int i = 0; i < 4; ++i) vt[(size_t)(e + 16 * i) * nk] = src[64 + e + 16 * i];
    }
  }
}

DI int crow(int i, int h) { return (i & 3) + 8 * (i >> 2) + 4 * h; }

template <int DQK, int NMAP>
DI void attn_wave(const Params& p, int l, const u16* __restrict__ Q, int qstride, int qmapstride,
                  const u16* __restrict__ K, size_t kmapstride, const u16* __restrict__ Vt, int nk, int orow0, int ocol0) {
  constexpr int NS = DQK / 16;
  const int lane = threadIdx.x & 63, r = lane & 31, h = lane >> 5;
  bf16x8 bq[NMAP][NS];
#pragma unroll
  for (int m = 0; m < NMAP; ++m)
#pragma unroll
    for (int s = 0; s < NS; ++s) bq[m][s] = *(const bf16x8*)(Q + (size_t)r * qstride + m * qmapstride + 16 * s + 8 * h);
  f32x16 O[NMAP][2];
  float mrun[NMAP], lsum[NMAP];
#pragma unroll
  for (int m = 0; m < NMAP; ++m) {
    mrun[m] = -1e30f; lsum[m] = 0.f;
#pragma unroll
    for (int mt = 0; mt < 2; ++mt)
#pragma unroll
      for (int i = 0; i < 16; ++i) O[m][mt][i] = 0.f;
  }
  for (int k0 = 0; k0 < nk; k0 += 32) {
    bf16x8 av[2][2];
#pragma unroll
    for (int mt = 0; mt < 2; ++mt)
#pragma unroll
      for (int s2 = 0; s2 < 2; ++s2) {
        const u16* vp = Vt + (size_t)(mt * 32 + r) * nk + k0 + 16 * s2 + 4 * h;
        bf16x4 lo = *(const bf16x4*)vp, hi = *(const bf16x4*)(vp + 8);
        av[mt][s2] = __builtin_shufflevector(lo, hi, 0, 1, 2, 3, 4, 5, 6, 7);
      }
#pragma unroll
    for (int m = 0; m < NMAP; ++m) {
      f32x16 acc;
#pragma unroll
      for (int i = 0; i < 16; ++i) acc[i] = 0.f;
      const u16* kp = K + m * kmapstride + (size_t)(k0 + r) * DQK + 8 * h;
#pragma unroll
      for (int s = 0; s < NS; ++s) {
        bf16x8 ak = *(const bf16x8*)(kp + 16 * s);
        acc = __builtin_amdgcn_mfma_f32_32x32x16_bf16(ak, bq[m][s], acc, 0, 0, 0);
      }
      float mx = acc[0];
#pragma unroll
      for (int i = 1; i < 16; ++i) mx = fmaxf(mx, acc[i]);
      mx = fmaxf(mx, __shfl_xor(mx, 32));
      const float mnew = fmaxf(mrun[m], mx);
      const float alpha = __builtin_amdgcn_exp2f(mrun[m] - mnew);
      mrun[m] = mnew;
      float ps = 0.f;
#pragma unroll
      for (int i = 0; i < 16; ++i) { acc[i] = __builtin_amdgcn_exp2f(acc[i] - mnew); ps += acc[i]; }
      lsum[m] = lsum[m] * alpha + ps;
#pragma unroll
      for (int mt = 0; mt < 2; ++mt)
#pragma unroll
        for (int i = 0; i < 16; ++i) O[m][mt][i] *= alpha;
      bf16x8 pf[2];
#pragma unroll
      for (int s2 = 0; s2 < 2; ++s2)
#pragma unroll
        for (int j = 0; j < 8; ++j) pf[s2][j] = (short)f2bf(acc[8 * s2 + j]);
#pragma unroll
      for (int mt = 0; mt < 2; ++mt)
#pragma unroll
        for (int s2 = 0; s2 < 2; ++s2)
          O[m][mt] = __builtin_amdgcn_mfma_f32_32x32x16_bf16(av[mt][s2], pf[s2], O[m][mt], 0, 0, 0);
    }
  }
  u16* OB = (u16*)(p.ws + WS_HB);
  u16* op = OB + (size_t)(orow0 + r) * 1024 + ocol0;
  if (NMAP == 1) {
    const float inv = 1.f / (lsum[0] + __shfl_xor(lsum[0], 32));
#pragma unroll
    for (int mt = 0; mt < 2; ++mt)
#pragma unroll
      for (int g = 0; g < 4; ++g) {
        uint2 o;
        o.x = pack2(O[0][mt][4 * g] * inv, O[0][mt][4 * g + 1] * inv);
        o.y = pack2(O[0][mt][4 * g + 2] * inv, O[0][mt][4 * g + 3] * inv);
        *(uint2*)(op + mt * 32 + 8 * g + 4 * h) = o;
      }
  } else {
    const float* dl = p.in[I_DLAM] + l * 128;
    float a = 0.f, b = 0.f;
    if (lane < 32) { a = dl[lane] * dl[32 + lane]; b = dl[64 + lane] * dl[96 + lane]; }
    a = wave_sum(a); b = wave_sum(b);
    const float lam_init = 0.8f - 0.6f * expf(-0.3f * (float)l);
    const float lam = expf(a) - expf(b) + lam_init;
    const float inv0 = 1.f / (lsum[0] + __shfl_xor(lsum[0], 32));
    const float inv1 = lam / (lsum[NMAP - 1] + __shfl_xor(lsum[NMAP - 1], 32));
    float ss = 0.f;
#pragma unroll
    for (int mt = 0; mt < 2; ++mt)
#pragma unroll
      for (int i = 0; i < 16; ++i) {
        float o = O[0][mt][i] * inv0 - O[NMAP - 1][mt][i] * inv1;
        O[0][mt][i] = o;
        ss += o * o;
      }
    ss += __shfl_xor(ss, 32);
    const float rstd = rsqrtf(ss * (1.f / 64.f) + EPS) * (1.f - lam_init);
    const float* sg = p.in[I_DSUBLN] + l * 64;
#pragma unroll
    for (int mt = 0; mt < 2; ++mt)
#pragma unroll
      for (int g = 0; g < 4; ++g) {
        const int dv = mt * 32 + 8 * g + 4 * h;
        uint2 o;
        o.x = pack2(O[0][mt][4 * g] * rstd * sg[dv], O[0][mt][4 * g + 1] * rstd * sg[dv + 1]);
        o.y = pack2(O[0][mt][4 * g + 2] * rstd * sg[dv + 2], O[0][mt][4 * g + 3] * rstd * sg[dv + 3]);
        *(uint2*)(op + dv) = o;
      }
  }
}

DI void mla_item(const Params& p, int l, int seq, int head, int qb) {
  const int w = threadIdx.x >> 6;
  const int nk = seq_nk(seq), row0 = seq_row0(seq), q0 = qb * 128 + w * 32;
  const size_t kvb = seq_kvb(seq);
  const u16* Q = (const u16*)(p.ws + WS_QM) + (size_t)(row0 + q0) * 384 + head * 96;
  const u16* K = (const u16*)(p.ws + WS_KM) + kvb * 384 + (size_t)head * nk * 96;
  const u16* Vt = (const u16*)(p.ws + WS_VTM) + kvb * 256 + (size_t)head * 64 * nk;
  attn_wave<96, 1>(p, l, Q, 384, 0, K, 0, Vt, nk, row0 + q0, 256 + head * 64);
}
DI void diff_item(const Params& p, int l, int seq, int head, int qb) {
  const int w = threadIdx.x >> 6;
  const int nk = seq_nk(seq), row0 = seq_row0(seq), q0 = qb * 128 + w * 32;
  const size_t kvb = seq_kvb(seq);
  const u16* Q = (const u16*)(p.ws + WS_QD) + (size_t)(row0 + q0) * 256 + head * 64;
  const u16* K = (const u16*)(p.ws + WS_KD) + kvb * 256 + (size_t)(head * 2) * nk * 32;
  const u16* Vt = (const u16*)(p.ws + WS_VTD) + kvb * 256 + (size_t)head * 64 * nk;
  attn_wave<32, 2>(p, l, Q, 256, 32, K, (size_t)nk * 32, Vt, nk, row0 + q0, 768 + head * 64);
}

DI void hgrn_item(const Params& p, int l, int seq, int head, int dir, char* smem) {
  float* qs = (float*)smem;
  float* ks = qs + 2048;
  float* vs = ks + 2048;
  const int tid = threadIdx.x, v = tid >> 2, kq = tid & 3, e = tid & 63;
  const int L = seq_nq(seq), row0 = seq_row0(seq);
  const bool ctx = seq < 32;
  const int b = ctx ? seq : seq - 32;
  const u16* PROJ = (const u16*)(p.ws + WS_ACT);
  float* OUTB = (float*)(p.ws + (dir ? WS_OBW : WS_OF));
  float oml;
  {
    const float* lg = p.in[I_LB] + (size_t)dir * 1024 + head * 64 + e;
    float l0 = lg[0], l1 = lg[256], l2 = lg[512], l3 = lg[768];
    float mx = fmaxf(fmaxf(l0, l1), fmaxf(l2, l3));
    float e0 = expf(l0 - mx), e1 = expf(l1 - mx), e2 = expf(l2 - mx), e3 = expf(l3 - mx);
    float tot = e0 + e1 + e2 + e3;
    float lb = ((l >= 1 ? e1 : 0.f) + (l >= 2 ? e2 : 0.f) + (l >= 3 ? e3 : 0.f)) / tot;
    oml = 1.f - lb;
  }
  float S[16];
  const size_t sbase = ((((size_t)b * 4 + l) * 2 + dir) * 4 + head) * 4096;
#pragma unroll
  for (int j = 0; j < 16; ++j) S[j] = ctx ? 0.f : p.in[I_SHG][sbase + (size_t)(kq * 16 + j) * 64 + v];
  const int foff = dir ? 768 : 512;
  for (int n0 = 0; n0 < L; n0 += 32) {
    __syncthreads();
    for (int idx = tid; idx < 2048; idx += 256) {
      const int tt = idx >> 6, n = n0 + tt, t = dir ? L - 1 - n : n;
      const u16* pr = PROJ + (size_t)(row0 + t) * INWP + head * 64 + e;
      const float xq = bf2f(pr[0]), xi = bf2f(pr[256]), xf = bf2f(pr[foff]);
      qs[idx] = silu_f(xq) * 0.125f;
      vs[idx] = xi;
      ks[idx] = fminf(oml * sigm_f(-xf), MAXK);
    }
    __syncthreads();
    for (int tt = 0; tt < 32; ++tt) {
      const float vt = vs[tt * 64 + v];
      float o = 0.f;
#pragma unroll
      for (int j4 = 0; j4 < 4; ++j4) {
        const float4 k4 = *(const float4*)&ks[tt * 64 + kq * 16 + j4 * 4];
        const float4 q4 = *(const float4*)&qs[tt * 64 + kq * 16 + j4 * 4];
        float* s = &S[j4 * 4];
        s[0] = fmaf(k4.x, vt - s[0], s[0]); o = fmaf(s[0], q4.x, o);
        s[1] = fmaf(k4.y, vt - s[1], s[1]); o = fmaf(s[1], q4.y, o);
        s[2] = fmaf(k4.z, vt - s[2], s[2]); o = fmaf(s[2], q4.z, o);
        s[3] = fmaf(k4.w, vt - s[3], s[3]); o = fmaf(s[3], q4.w, o);
      }
      o += __shfl_xor(o, 1);
      o += __shfl_xor(o, 2);
      if (kq == 0) {
        const int n = n0 + tt, t = dir ? L - 1 - n : n;
        OUTB[(size_t)(row0 + t) * 256 + head * 64 + v] = o;
      }
    }
  }
  if (ctx) {
#pragma unroll
    for (int j = 0; j < 16; ++j) p.out[O_HG + sbase + (size_t)(kq * 16 + j) * 64 + v] = S[j];
  }
}

template <int N>
DI void hyena_item(const Params& p, int l, int seq, int ch, char* smem) {
  constexpr int NT = N / 256;
  float* fl = (float*)smem;
  float* uv = fl + 2 * N;
  float* z1 = uv + N;
  float* x1s = z1 + N;
  float* x2s = x1s + N;
  const int tid = threadIdx.x;
  const int row0 = seq_row0(seq);
  const u16* PROJ = (const u16*)(p.ws + WS_ACT);
  const float* wsh = p.in[I_HYSHORT] + (size_t)l * 3 * 768;
  float wv[3], wa[3], wb[3];
#pragma unroll
  for (int j = 0; j < 3; ++j) { wv[j] = wsh[j * 768 + ch]; wa[j] = wsh[j * 768 + 256 + ch]; wb[j] = wsh[j * 768 + 512 + ch]; }
  __syncthreads();
#pragma unroll
  for (int i = 0; i < NT; ++i) {
    const int t = tid + 256 * i;
    float a = 0.f, b = 0.f, c = 0.f;
#pragma unroll
    for (int j = 0; j < 3; ++j) {
      const int tt = t + j - 1;
      if (tt >= 0 && tt < N) {
        const u16* pr = PROJ + (size_t)(row0 + tt) * INWP + 1696 + ch;
        a += wv[j] * bf2f(pr[0]); b += wa[j] * bf2f(pr[256]); c += wb[j] * bf2f(pr[512]);
      }
    }
    uv[t] = a; x1s[t] = b; x2s[t] = c;
  }
  const float* FB = filt_ptr(p, l, N == 2048 ? 1 : 0);
  const float* F0 = FB + (size_t)ch * 2 * N;
  const float* F1 = FB + (size_t)(256 + ch) * 2 * N;
  for (int i = tid; i < 2 * N; i += 256) fl[i] = F0[i];
  __syncthreads();
  const float bias0 = p.in[I_HYBIAS][(l * 2 + 0) * 256 + ch], bias1 = p.in[I_HYBIAS][(l * 2 + 1) * 256 + ch];
  {
    float y[NT];
#pragma unroll
    for (int i = 0; i < NT; ++i) y[i] = 0.f;
    const float* fb = fl + tid + N;
    for (int s = 0; s < N; s += 4) {
      const float4 u4 = *(const float4*)&uv[s];
#pragma unroll
      for (int i = 0; i < NT; ++i) {
        const float* f = fb + 256 * i - s;
        y[i] = fmaf(u4.x, f[0], y[i]); y[i] = fmaf(u4.y, f[-1], y[i]); y[i] = fmaf(u4.z, f[-2], y[i]); y[i] = fmaf(u4.w, f[-3], y[i]);
      }
    }
#pragma unroll
    for (int i = 0; i < NT; ++i) { const int t = tid + 256 * i; z1[t] = x1s[t] * (y[i] + uv[t] * bias0); }
  }
  __syncthreads();
  for (int i = tid; i < 2 * N; i += 256) fl[i] = F1[i];
  __syncthreads();
  {
    float y[NT];
#pragma unroll
    for (int i = 0; i < NT; ++i) y[i] = 0.f;
    const float* fb = fl + tid + N;
    for (int s = 0; s < N; s += 4) {
      const float4 u4 = *(const float4*)&z1[s];
#pragma unroll
      for (int i = 0; i < NT; ++i) {
        const float* f = fb + 256 * i - s;
        y[i] = fmaf(u4.x, f[0], y[i]); y[i] = fmaf(u4.y, f[-1], y[i]); y[i] = fmaf(u4.z, f[-2], y[i]); y[i] = fmaf(u4.w, f[-3], y[i]);
      }
    }
    u16* OB = (u16*)(p.ws + WS_HB);
#pragma unroll
    for (int i = 0; i < NT; ++i) {
      const int t = tid + 256 * i;
      OB[(size_t)(row0 + t) * 1024 + 512 + ch] = f2bf(x2s[t] * (y[i] + z1[t] * bias1));
    }
  }
}

DI void phase_mix(const Params& p, int l, char* smem) {
  const int G = gridDim.x;
  int rot = 0;
#define MIX_LOOP(COUNT, BODY)                                                        \
  {                                                                                  \
    int first = (int)blockIdx.x - rot; if (first < 0) first += G;                    \
    for (int j = first; j < (COUNT); j += G) { BODY; }                               \
    rot = (rot + (COUNT)) % G;                                                       \
  }
  MIX_LOOP(64, hgrn_item(p, l, 32 + (j >> 3), (j >> 1) & 3, j & 1, smem))
  MIX_LOOP(512, mla_item(p, l, 32 + (j >> 6), (j >> 4) & 3, j & 15))
  MIX_LOOP(512, diff_item(p, l, 32 + (j >> 6), (j >> 4) & 3, j & 15))
  MIX_LOOP(2048, hyena_item<2048>(p, l, 32 + (j >> 8), j & 255, smem))
  MIX_LOOP(256, hgrn_item(p, l, j >> 3, (j >> 1) & 3, j & 1, smem))
  MIX_LOOP(256, mla_item(p, l, j >> 3, (j >> 1) & 3, j & 1))
  MIX_LOOP(256, diff_item(p, l, j >> 3, (j >> 1) & 3, j & 1))
  MIX_LOOP(8192, hyena_item<256>(p, l, j >> 8, j & 255, smem))
#undef MIX_LOOP
}

DI void phase_hcomb(const Params& p, int l) {
  const int lane = threadIdx.x & 63;
  const int gw = blockIdx.x * 4 + (threadIdx.x >> 6), nw = gridDim.x * 4;
  const u16* PROJ = (const u16*)(p.ws + WS_ACT);
  const float* OF = (const float*)(p.ws + WS_OF);
  const float* OBW = (const float*)(p.ws + WS_OBW);
  u16* OB = (u16*)(p.ws + WS_HB);
  const float* g = p.in[I_ONORM] + l * 64 + (lane & 15) * 4;
  for (int r = gw; r < MTOK; r += nw) {
    float4 a = *(const float4*)(OF + (size_t)r * 256 + lane * 4);
    float4 b = *(const float4*)(OBW + (size_t)r * 256 + lane * 4);
    float o0 = a.x + b.x, o1 = a.y + b.y, o2 = a.z + b.z, o3 = a.w + b.w;
    float ss = o0 * o0 + o1 * o1 + o2 * o2 + o3 * o3;
    ss += __shfl_xor(ss, 1); ss += __shfl_xor(ss, 2); ss += __shfl_xor(ss, 4); ss += __shfl_xor(ss, 8);
    const float rstd = rsqrtf(ss * (1.f / 64.f) + EPS);
    uint2 raw = *(const uint2*)(PROJ + (size_t)r * INWP + 1024 + lane * 4);
    uint2 o;
    o.x = pack2(o0 * rstd * g[0] * silu_f(bflo(raw.x)), o1 * rstd * g[1] * silu_f(bfhi(raw.x)));
    o.y = pack2(o2 * rstd * g[2] * silu_f(bflo(raw.y)), o3 * rstd * g[3] * silu_f(bfhi(raw.y)));
    *(uint2*)(OB + (size_t)r * 1024 + lane * 4) = o;
  }
}

enum { PH_PRO = 0, PH_FILTNORM, PH_ADALN0, PH_GU0, PH_DN0, PH_ADALN1, PH_GIN, PH_PREP1, PH_GSMALL, PH_PREP2, PH_MIX, PH_HCOMB,
       PH_GOUT, PH_ADALN2, PH_GU1, PH_DN1, PH_COUNT };

DI void run_phase(const Params& p, int ph, int l, char* smem) {
  const u16* HB = (const u16*)(p.ws + WS_HB);
  u16* ACT = (u16*)(p.ws + WS_ACT);
  const float* MOD = (const float*)(p.ws + WS_MOD) + (size_t)l * 9 * 9216;
  switch (ph) {
    case PH_PRO: phase_wprep(p, smem); phase_mod(p, smem); phase_rope(p); phase_filt(p, smem); phase_copyx(p); break;
    case PH_FILTNORM: phase_filtnorm(p); break;
    case PH_ADALN0: phase_adaln(p, l, 0); break;
    case PH_ADALN1: phase_adaln(p, l, 1); break;
    case PH_ADALN2: phase_adaln(p, l, 2); break;
    case PH_GU0:
    case PH_GU1: {
      const int f = ph == PH_GU1;
      Epi e{ACT, DFF, nullptr, nullptr, 0.f};
      phase_gemm<EPI_GU>(HB, 1024, (const u16*)(p.ws + WS_WGU) + (size_t)(l * 2 + f) * 5632 * 1024, 1024, MTOK, 5632, 1024, e, smem);
    } break;
    case PH_DN0:
    case PH_DN1: {
      const int f = ph == PH_DN1;
      Epi e{nullptr, 0, p.out, MOD + (f ? 8192 : 2048), 0.5f};
      phase_gemm<EPI_RESID>(ACT, DFF, (const u16*)(p.ws + WS_WDN) + (size_t)(l * 2 + f) * 1024 * 2816, 2816, MTOK, 1024, 2816, e, smem);
    } break;
    case PH_GIN: {
      Epi e{ACT, INWP, nullptr, nullptr, 0.f};
      phase_gemm<EPI_BF16>(HB, 1024, (const u16*)(p.ws + WS_WIN) + (size_t)l * 3328 * 1024, 1024, MTOK, 3328, 1024, e, smem);
    } break;
    case PH_PREP1: phase_prep1(p, l); break;
    case PH_GSMALL: phase_gsmall(p, l, smem); break;
    case PH_PREP2: phase_prep2(p, l); break;
    case PH_MIX: phase_mix(p, l, smem); break;
    case PH_HCOMB: phase_hcomb(p, l); break;
    case PH_GOUT: {
      Epi e{nullptr, 0, p.out, MOD + 5120, 1.0f};
      phase_gemm<EPI_RESID>(HB, 1024, (const u16*)(p.ws + WS_WOUT) + (size_t)l * 1024 * 1024, 1024, MTOK, 1024, 1024, e, smem);
    } break;
    default: break;
  }
}

constexpr int SMEM_BYTES = 49152;

__global__ void __launch_bounds__(256, 2) k_phase(Params p, int ph, int l) {
  __shared__ __attribute__((aligned(16))) char smem[SMEM_BYTES];
  run_phase(p, ph, l, smem);
}

#if MEGA
__global__ void __launch_bounds__(256, 2) k_mega(Params p) {
  __shared__ __attribute__((aligned(16))) char smem[SMEM_BYTES];
  cg::grid_group grid = cg::this_grid();
  run_phase(p, PH_PRO, 0, smem);
  grid.sync();
  run_phase(p, PH_FILTNORM, 0, smem);
  grid.sync();
  for (int l = 0; l < 4; ++l) {
    for (int ph = PH_ADALN0; ph < PH_COUNT; ++ph) {
      run_phase(p, ph, l, smem);
      grid.sync();
    }
  }
}

#endif

extern "C" void kernel_launch(void* const* d_in, const int* in_sizes, int n_in, void* d_out, int out_size, void* d_ws,
                              size_t ws_size, hipStream_t stream) {
  Params p{};
  for (int i = 0; i < 33; ++i) p.in[i] = (const float*)d_in[i];
  p.out = (float*)d_out;
  p.ws = (char*)d_ws;
  if (ws_size < WS_END || n_in < 33) {
    fprintf(stderr, "workspace too small: %zu < %zu\n", ws_size, (size_t)WS_END);
    return;
  }
#if MEGA
  static int grid_blocks = 0;
  if (!grid_blocks) {
    int dev = 0, cus = 0, per_cu = 0;
    hipGetDevice(&dev);
    hipDeviceGetAttribute(&cus, hipDeviceAttributeMultiprocessorCount, dev);
    hipOccupancyMaxActiveBlocksPerMultiprocessor(&per_cu, k_mega, 256, 0);
    if (per_cu > 2) per_cu = 2;
    grid_blocks = cus * per_cu;
  }
  void* args[] = {&p};
  hipError_t e = hipLaunchCooperativeKernel((void*)k_mega, dim3(grid_blocks), dim3(256), args, 0, stream);
  if (e != hipSuccess) fprintf(stderr, "cooperative launch failed: %s (grid %d)\n", hipGetErrorString(e), grid_blocks);
#else
  const int G = 512;
  k_phase<<<G, 256, 0, stream>>>(p, PH_PRO, 0);
  k_phase<<<G, 256, 0, stream>>>(p, PH_FILTNORM, 0);
  for (int l = 0; l < 4; ++l)
    for (int ph = PH_ADALN0; ph < PH_COUNT; ++ph) k_phase<<<G, 256, 0, stream>>>(p, ph, l);
#endif
}
```

```cpp
#include <hip/hip_runtime.h>
#include <hip/hip_cooperative_groups.h>
#include <cstdio>
namespace cg = cooperative_groups;

#ifndef MEGA
#define MEGA 1
#endif

typedef unsigned short u16;
using bf16x8 = __attribute__((ext_vector_type(8))) short;
using bf16x4 = __attribute__((ext_vector_type(4))) short;
using f32x4 = __attribute__((ext_vector_type(4))) float;
using f32x16 = __attribute__((ext_vector_type(16))) float;
using u32x4 = __attribute__((ext_vector_type(4))) unsigned;
#define DI __device__ __forceinline__

constexpr int NT = 512, NW = 8;
constexpr int NCTX = 8192, NLAT = 16384, MTOK = 24576, NKV = 28672;
constexpr int DFF = 2816, INWP = 3328;
constexpr float EPS = 1e-6f;
constexpr float LOG2E = 1.4426950408889634f;
constexpr float MAXK = 1.0f - 1e-6f;

constexpr size_t O_MLA = 25165824, O_DK = 30408704, O_DV = 38797312, O_HG = 47185920;

constexpr size_t WS_WGU = 0;
constexpr size_t WS_WDN = WS_WGU + (size_t)8 * 5632 * 1024 * 2;
constexpr size_t WS_WIN = WS_WDN + (size_t)8 * 1024 * 2816 * 2;
constexpr size_t WS_WOUT = WS_WIN + (size_t)4 * 3328 * 1024 * 2;
constexpr size_t WS_WUQ = WS_WOUT + (size_t)4 * 1024 * 1024 * 2;
constexpr size_t WS_WUKV = WS_WUQ + (size_t)4 * 512 * 256 * 2;
constexpr size_t WS_MOD = WS_WUKV + (size_t)4 * 512 * 256 * 2;
constexpr size_t WS_ROPE = WS_MOD + (size_t)4 * 9 * 9216 * 4;
constexpr size_t WS_FILT = WS_ROPE + (size_t)2048 * 32 * 4;
constexpr size_t FILT_L = 2359296;
constexpr size_t WS_HB = WS_FILT + (size_t)4 * FILT_L * 4;
constexpr size_t WS_ACT = WS_HB + (size_t)MTOK * 1024 * 2;
constexpr size_t WS_CQ = WS_ACT + (size_t)MTOK * 3328 * 2;
constexpr size_t WS_CKV = WS_CQ + (size_t)MTOK * 256 * 2;
constexpr size_t WS_QRAW = WS_CKV + (size_t)NKV * 256 * 2;
constexpr size_t WS_KVRAW = WS_QRAW + (size_t)MTOK * 256 * 4;
constexpr size_t WS_OF = WS_QRAW;
constexpr size_t WS_OBW = WS_KVRAW;
constexpr size_t WS_QM = WS_KVRAW + (size_t)NKV * 512 * 2;
constexpr size_t WS_KM = WS_QM + (size_t)MTOK * 384 * 2;
constexpr size_t WS_VTM = WS_KM + (size_t)NKV * 384 * 2;
constexpr size_t WS_QD = WS_VTM + (size_t)NKV * 256 * 2;
constexpr size_t WS_KD = WS_QD + (size_t)MTOK * 256 * 2;
constexpr size_t WS_VTD = WS_KD + (size_t)NKV * 256 * 2;
constexpr size_t WS_HT = WS_VTD + (size_t)NKV * 256 * 2;
constexpr size_t WS_HO = WS_HT + (size_t)768 * MTOK * 2;
constexpr size_t WS_CTR = WS_HO + (size_t)256 * MTOK * 2;
constexpr size_t WS_BAR = WS_CTR + 256;
constexpr size_t WS_PCNT = WS_BAR + 16384;
constexpr size_t WS_END = WS_PCNT + 12 * 128 * 4;
constexpr int XST_OFF = 140288;
constexpr int SLOT_OFF = XST_OFF + 16;

struct Params {
  const float* in[33];
  float* out;
  char* ws;
};
typedef const __attribute__((address_space(4))) Params CParams;
enum { I_XP = 0, I_XS, I_C, I_CMLA, I_CDK, I_CDV, I_SHG, I_CCTX, I_WMOD, I_BMOD, I_NORMG, I_WGU, I_WDN, I_WIN, I_WOUT,
       I_LB, I_ONORM, I_QNORM, I_KVNORM, I_WUQ, I_WUKV, I_QKNORM, I_HYSHORT, I_HYW1, I_HYB1, I_HYW2, I_HYB2, I_HYW3,
       I_HYDEC, I_HYBIAS, I_DQKNORM, I_DLAM, I_DSUBLN };

#define LAS __attribute__((address_space(3)))
DI int TID() { int t = threadIdx.x; asm volatile("" : "+v"(t)); return t; }
DI int BID() { int t = blockIdx.x; asm volatile("" : "+s"(t)); return t; }
DI u16 f2bf(float x) { unsigned u = __float_as_uint(x); u += 0x7fffu + ((u >> 16) & 1u); return (u16)(u >> 16); }
DI float bf2f(u16 b) { return __uint_as_float(((unsigned)b) << 16); }
DI float bflo(unsigned u) { return __uint_as_float(u << 16); }
DI float bfhi(unsigned u) { return __uint_as_float(u & 0xffff0000u); }
typedef float f32x2v __attribute__((ext_vector_type(2)));
typedef __bf16 b16x2v __attribute__((ext_vector_type(2)));
DI unsigned pack2(float a, float b) { f32x2v v = {a, b}; return __builtin_bit_cast(unsigned, __builtin_convertvector(v, b16x2v)); }
DI float silu_f(float x) { return x * __builtin_amdgcn_rcpf(1.f + __builtin_amdgcn_exp2f(-x * LOG2E)); }
DI float sigm_f(float x) { return __builtin_amdgcn_rcpf(1.f + __builtin_amdgcn_exp2f(-x * LOG2E)); }
DI float wave_sum(float v) { for (int o = 32; o; o >>= 1) v += __shfl_xor(v, o); return v; }

DI int seq_nk(int s) { return s < 32 ? 256 : 2560; }
DI int seq_nq(int s) { return s < 32 ? 256 : 2048; }
DI size_t seq_kvb(int s) { return s < 32 ? (size_t)s * 256 : (size_t)8192 + (size_t)(s - 32) * 2560; }
DI int seq_row0(int s) { return s < 32 ? s * 256 : 8192 + (s - 32) * 2048; }

DI void transpose_tile(const float* __restrict__ src, int ldsrc, u16* __restrict__ dst, int lddst, int n0, int k0,
                       int nvalid, int kvalid, int mode, float* tile) {
  const int tid = TID();
  {
    const int n4 = (tid & 15) * 4, kq = tid >> 4;
    const int n = n0 + n4;
    int col = n;
    if (mode == 1) {
      const int tl = n >> 8, sl = n & 255, bj = sl >> 7, wc_ = (sl >> 5) & 3, nn = (sl >> 4) & 1, fq_ = (sl >> 2) & 3, j_ = sl & 3;
      const int o = tl * 128 + 8 * (wc_ * 4 + fq_) + bj * 4 + j_;
      col = nn ? 2816 + o : o;
    } else {
      const int rho = n & 31;
      col = (n & ~31) + 8 * ((rho & 15) >> 2) + 4 * (rho >> 4) + (rho & 3);
    }
    const bool valid = (mode == 1) ? true : (col < nvalid);
#pragma unroll
    for (int i = 0; i < 2; ++i) {
      const int k = i * 32 + kq;
      f32x4 v = {0.f, 0.f, 0.f, 0.f};
      if (valid && (k0 + k) < kvalid) v = *(const f32x4*)(src + (size_t)(k0 + k) * ldsrc + col);
      float* tp = tile + k * 65 + n4;
      tp[0] = v[0]; tp[1] = v[1]; tp[2] = v[2]; tp[3] = v[3];
    }
  }
  __syncthreads();
  {
    const int kc = tid & 7, n = tid >> 3;
    const float* tp = tile + (kc * 8) * 65 + n;
    u32x4 o;
    o.x = pack2(tp[0], tp[65]); o.y = pack2(tp[130], tp[195]); o.z = pack2(tp[260], tp[325]); o.w = pack2(tp[390], tp[455]);
    *(u32x4*)(dst + (size_t)(n0 + n) * lddst + k0 + kc * 8) = o;
  }
  __syncthreads();
}

constexpr int WP_TILES = 5376;
DI void wprep_range(CParams& p, char* smem, int L, int jb, int je, int worker, int nworkers) {
  float* tile = (float*)smem;
  for (int j0 = jb + worker; j0 < je; j0 += nworkers) {
    int j = j0;
    if (j < 2816) {
      int f = j / 1408, rem = j % 1408, nt = rem / 16, kt = rem % 16, mat = L * 2 + f;
      transpose_tile(p.in[I_WGU] + (size_t)mat * 1024 * 5632, 5632, (u16*)(p.ws + WS_WGU) + (size_t)mat * 5632 * 1024, 1024,
                     nt * 64, kt * 64, 5632, 1024, 1, tile);
      continue;
    }
    j -= 2816;
    if (j < 1408) {
      int f = j / 704, rem = j % 704, nt = rem / 44, kt = rem % 44, mat = L * 2 + f;
      transpose_tile(p.in[I_WDN] + (size_t)mat * 2816 * 1024, 1024, (u16*)(p.ws + WS_WDN) + (size_t)mat * 1024 * 2816, 2816,
                     nt * 64, kt * 64, 1024, 2816, 0, tile);
      continue;
    }
    j -= 1408;
    if (j < 832) {
      int nt = j / 16, kt = j % 16;
      transpose_tile(p.in[I_WIN] + (size_t)L * 1024 * 3232, 3232, (u16*)(p.ws + WS_WIN) + (size_t)L * 3328 * 1024, 1024,
                     nt * 64, kt * 64, 3232, 1024, 0, tile);
      continue;
    }
    j -= 832;
    if (j < 256) {
      int nt = j / 16, kt = j % 16;
      transpose_tile(p.in[I_WOUT] + (size_t)L * 1024 * 1024, 1024, (u16*)(p.ws + WS_WOUT) + (size_t)L * 1024 * 1024, 1024,
                     nt * 64, kt * 64, 1024, 1024, 0, tile);
      continue;
    }
    j -= 256;
    if (j < 32) {
      int nt = j / 4, kt = j % 4;
      transpose_tile(p.in[I_WUQ] + (size_t)L * 256 * 384, 384, (u16*)(p.ws + WS_WUQ) + (size_t)L * 512 * 256, 256,
                     nt * 64, kt * 64, 384, 256, 0, tile);
      continue;
    }
    j -= 32;
    {
      int nt = j / 4, kt = j % 4;
      transpose_tile(p.in[I_WUKV] + (size_t)L * 128 * 512, 512, (u16*)(p.ws + WS_WUKV) + (size_t)L * 512 * 256, 256,
                     nt * 64, kt * 64, 512, 128, 0, tile);
    }
  }
}
DI void phase_wprep(CParams& p, char* smem) { wprep_range(p, smem, 0, 0, WP_TILES, BID(), gridDim.x); }

DI void phase_mod(CParams& p, char* smem) {
  float* s = (float*)smem;
  float* red = s + 9 * 1024;
  const int tid = TID(), lane = tid & 63, w = tid >> 6;
  float* MOD = (float*)(p.ws + WS_MOD);
  for (int id = BID(); id < 144; id += gridDim.x) {
    const int l = id / 36, n0 = (id % 36) * 256;
    __syncthreads();
    for (int i = tid; i < 9 * 1024; i += NT) {
      int c = i >> 10, k = i & 1023;
      float x = (c == 0) ? p.in[I_CCTX][k] : p.in[I_C][(c - 1) * 1024 + k];
      s[i] = silu_f(x);
    }
    __syncthreads();
    f32x4 acc[9];
#pragma unroll
    for (int c = 0; c < 9; ++c) acc[c] = f32x4{0.f, 0.f, 0.f, 0.f};
    const float* wp = p.in[I_WMOD] + ((size_t)l * 1024 + w * 128) * 9216 + n0 + lane * 4;
#pragma unroll 4
    for (int k = 0; k < 128; ++k) {
      const f32x4 wv = *(const f32x4*)(wp + (size_t)k * 9216);
#pragma unroll
      for (int c = 0; c < 9; ++c) acc[c] += wv * s[c * 1024 + w * 128 + k];
    }
#pragma unroll
    for (int c = 0; c < 9; ++c) *(f32x4*)&red[(w * 9 + c) * 256 + lane * 4] = acc[c];
    __syncthreads();
    for (int i = tid; i < 9 * 256; i += NT) {
      int c = i >> 8, ln = i & 255;
      float v = 0.f;
#pragma unroll
      for (int ww = 0; ww < NW; ++ww) v += red[(ww * 9 + c) * 256 + ln];
      MOD[((size_t)l * 9 + c) * 9216 + n0 + ln] = v + p.in[I_BMOD][l * 9216 + n0 + ln];
    }
  }
}

DI void phase_rope(CParams& p) {
  float* R = (float*)(p.ws + WS_ROPE);
  for (int i = BID() * NT + TID(); i < 2048 * 16; i += gridDim.x * NT) {
    int t = i >> 4, k = i & 15;
    float pos = (k < 8) ? (float)(t >> 6) : (float)(t & 63);
    float inv = powf(10000.f, -(float)(k & 7) / 8.f);
    float ang = pos * inv;
    R[t * 32 + k] = cosf(ang);
    R[t * 32 + 16 + k] = sinf(ang);
  }
}

DI float* filt_ptr(CParams& p, int l, int kind) { return (float*)(p.ws + WS_FILT) + (size_t)l * FILT_L + (kind ? 262144 : 0); }

DI void phase_filt(CParams& p, char* smem) {
  float* h1 = (float*)smem;
  float* h2 = h1 + 1024;
  const int tid = TID(), unit = tid & 63, tq = tid >> 6;
  for (int id = BID(); id < 576; id += gridDim.x) {
    const int l = id / 144, rem = id % 144;
    const int kind = rem < 16 ? 0 : 1, tb = rem < 16 ? rem : rem - 16;
    const int n = kind ? 2048 : 256, tau0 = tb * 16;
    const float* w1 = p.in[I_HYW1] + (size_t)l * 17 * 64;
    const float* w2 = p.in[I_HYW2] + (size_t)l * 64 * 64;
    const float* w3 = p.in[I_HYW3] + (size_t)l * 64 * 1024;
    __syncthreads();
    for (int j = 0; j < 2; ++j) {
      int ti = tq + 8 * j;
      float tn = (float)(tau0 + ti) / (float)n;
      float a = 6.283185307179586f * tn;
      float sacc = p.in[I_HYB1][l * 64 + unit] + tn * w1[unit];
      for (int k = 1; k <= 8; ++k) {
        float ak = a * (float)k;
        sacc += cosf(ak) * w1[k * 64 + unit] + sinf(ak) * w1[(8 + k) * 64 + unit];
      }
      h1[ti * 64 + unit] = sinf(sacc);
    }
    __syncthreads();
    for (int j = 0; j < 2; ++j) {
      int ti = tq + 8 * j;
      float sacc = p.in[I_HYB2][l * 64 + unit];
      for (int i = 0; i < 64; ++i) sacc += h1[ti * 64 + i] * w2[i * 64 + unit];
      h2[ti * 64 + unit] = sinf(sacc);
    }
    __syncthreads();
    float* FB = filt_ptr(p, l, kind);
    for (int cc = 0; cc < 2; ++cc) {
      const int col = tid + NT * cc;
      float wc[64];
#pragma unroll
      for (int i = 0; i < 64; ++i) wc[i] = w3[i * 1024 + col];
      const float dec = expf(p.in[I_HYDEC][l * 1024 + col]);
      const int dir = col >> 9, oc = col & 511;
      float* F = FB + (size_t)oc * 2 * n;
      for (int ti = 0; ti < 16; ++ti) {
        float v = 0.f;
#pragma unroll
        for (int i = 0; i < 64; ++i) v += h2[ti * 64 + i] * wc[i];
        const int tau = tau0 + ti;
        v *= expf(-dec * ((float)tau / (float)n));
        if (dir == 0) F[n + tau] = v;
        else if (tau >= 1) F[n - tau] = v;
        else F[0] = 0.f;
      }
    }
  }
}

DI void phase_filtnorm(CParams& p) {
  const int lane = TID() & 63;
  const int gw = BID() * NW + (TID() >> 6), nw = gridDim.x * NW;
  for (int id = gw; id < 4096; id += nw) {
    const int l = id >> 10, rem = id & 1023, kind = rem >> 9, oc = rem & 511;
    const int n2 = kind ? 4096 : 512;
    float* F = filt_ptr(p, l, kind) + (size_t)oc * n2;
    float s = 0.f;
    for (int i = lane; i < n2; i += 64) s += fabsf(F[i]);
    s = wave_sum(s);
    const float sc = 1.f / (s + EPS);
    for (int i = lane; i < n2; i += 64) F[i] *= sc;
  }
}

DI void phase_copyx(CParams& p) {
  float4* dst = (float4*)p.out;
  const float4* a = (const float4*)p.in[I_XP];
  const float4* b = (const float4*)p.in[I_XS];
  const size_t na = (size_t)NCTX * 256, nb = (size_t)NLAT * 256;
  for (size_t i = (size_t)BID() * NT + TID(); i < na + nb; i += (size_t)gridDim.x * NT)
    dst[i] = i < na ? a[i] : b[i - na];
}

#define XB_TMO      128
#define XB_XCNT(j)  (256  + 64 * (j))
#define XB_XSUB(j)  (1280 + 64 * (j))
#define XB_XGEN(j)  (2304 + 64 * (j))
#define XB_TOP      3328
#define XB_TOPGEN   3392
#define XCD_BAR_WORDS 3456
#define XB_SPIN_CAP (1u << 22)
DI unsigned xb_ld(unsigned* p) { return __hip_atomic_load(p, __ATOMIC_RELAXED, __HIP_MEMORY_SCOPE_AGENT); }
DI unsigned xb_add(unsigned* p, unsigned v) { return __hip_atomic_fetch_add(p, v, __ATOMIC_RELAXED, __HIP_MEMORY_SCOPE_AGENT); }
DI unsigned xb_xcc_id() { return (unsigned)__builtin_amdgcn_s_getreg((3 << 11) | 20) & 0xFu; }
#define XB_SPIN(cond, bar) do { unsigned _sp = 0; while (cond) { __builtin_amdgcn_s_sleep(1); \
    if ((++_sp & 255u) == 0u) { if (xb_ld(&(bar)[XB_TMO])) break; if (_sp > XB_SPIN_CAP) { atomicAdd(&(bar)[XB_TMO], 1u); break; } } } } while (0)
struct XcdBarrier { unsigned* bar; unsigned x; volatile LAS unsigned* st; };
DI XcdBarrier xcd_barrier_post(unsigned* bar, volatile LAS unsigned* st) {
  XcdBarrier b; b.bar = bar; b.x = xb_xcc_id(); b.st = st;
  if (threadIdx.x == 0) (void)xb_add(&bar[XB_XCNT(b.x)], 1u);
  return b;
}
DI void xcd_barrier_complete(unsigned* bar, unsigned x, unsigned& nloc, unsigned& nx) {
  const unsigned G = gridDim.x * gridDim.y * gridDim.z;
  unsigned sum, cnt, mine, sp = 0u;
  for (;;) {
    sum = 0u; cnt = 0u; mine = 0u;
#pragma unroll
    for (unsigned j = 0; j < 16; ++j) { const unsigned c = xb_ld(&bar[XB_XCNT(j)]); sum += c; cnt += (c > 0u) ? 1u : 0u; mine = (j == x) ? c : mine; }
    if (sum == G) break;
    __builtin_amdgcn_s_sleep(1);
    if ((++sp & 255u) == 0u) { if (xb_ld(&bar[XB_TMO])) break; if (sp > XB_SPIN_CAP) { atomicAdd(&bar[XB_TMO], 1u); break; } }
  }
  nloc = mine > 0u ? mine : 1u; nx = cnt > 0u ? cnt : 1u;
}
DI void xcd_barrier(const XcdBarrier& b) {
  asm volatile("s_waitcnt vmcnt(0)" ::: "memory");
  __syncthreads();
  if (threadIdx.x == 0) {
    unsigned* bar = b.bar;
    __builtin_amdgcn_s_waitcnt(0);
    unsigned nloc = b.st[0], nx = b.st[1];
    if (nloc == 0u) { xcd_barrier_complete(bar, b.x, nloc, nx); b.st[0] = nloc; b.st[1] = nx; }
    const unsigned old = xb_add(&bar[XB_XSUB(b.x)], 1u);
    const unsigned gen = old / nloc;
    if (old + 1u == (gen + 1u) * nloc) {
      __builtin_amdgcn_fence(__ATOMIC_RELEASE, "agent");
      asm volatile("s_waitcnt vmcnt(0)" ::: "memory");
      const unsigned og = xb_add(&bar[XB_TOP], 1u);
      const unsigned tg = og / nx;
      if (og + 1u == (tg + 1u) * nx) xb_add(&bar[XB_TOPGEN], 1u);
      else XB_SPIN(xb_ld(&bar[XB_TOPGEN]) == tg, bar);
      __builtin_amdgcn_fence(__ATOMIC_ACQUIRE, "agent");
      xb_add(&bar[XB_XGEN(b.x)], 1u);
      asm volatile("s_waitcnt vmcnt(0)" ::: "memory");
    } else {
      XB_SPIN(xb_ld(&bar[XB_XGEN(b.x)]) == gen, bar);
      __builtin_amdgcn_fence(__ATOMIC_ACQUIRE, "agent");
      asm volatile("s_waitcnt vmcnt(0)" ::: "memory");
    }
  }
  __syncthreads();
}

DI void adaln_rows(CParams& p, int l, int which, int gw, int nw, int MTOK_END, bool from_inputs = false);
DI void phase_adaln(CParams& p, int l, int which) {
  adaln_rows(p, l, which, BID() * NW + (TID() >> 6), gridDim.x * NW, MTOK);
}
DI void adaln_rows(CParams& p, int l, int which, int gw, int nw, int rend, bool from_inputs) {
  const int lane = TID() & 63;
  const float* MOD = (const float*)(p.ws + WS_MOD);
  u16* HB = (u16*)(p.ws + WS_HB);
  const float* g = p.in[I_NORMG] + (size_t)(l * 3 + which) * 1024;
  constexpr int RB = 4;
  for (int r0 = gw; r0 < rend; r0 += nw * RB) {
    float4 v[RB][4];
#pragma unroll
    for (int q = 0; q < RB; ++q) {
      const int r = r0 + q * nw;
      if (r < rend) {
        const float* x = (from_inputs ? (r < NCTX ? p.in[I_XP] + (size_t)r * 1024 : p.in[I_XS] + (size_t)(r - NCTX) * 1024) : p.out + (size_t)r * 1024);
#pragma unroll
        for (int i = 0; i < 4; ++i) {
          v[q][i] = *(const float4*)(x + i * 256 + lane * 4);
          if (from_inputs) *(float4*)(p.out + (size_t)r * 1024 + i * 256 + lane * 4) = v[q][i];
        }
      } else {
#pragma unroll
        for (int i = 0; i < 4; ++i) v[q][i] = float4{0.f, 0.f, 0.f, 0.f};
      }
    }
    float ss[RB];
#pragma unroll
    for (int q = 0; q < RB; ++q) {
      ss[q] = 0.f;
#pragma unroll
      for (int i = 0; i < 4; ++i) ss[q] += v[q][i].x * v[q][i].x + v[q][i].y * v[q][i].y + v[q][i].z * v[q][i].z + v[q][i].w * v[q][i].w;
    }
#pragma unroll
    for (int o = 32; o; o >>= 1)
#pragma unroll
      for (int q = 0; q < RB; ++q) ss[q] += __shfl_xor(ss[q], o);
#pragma unroll
    for (int q = 0; q < RB; ++q) {
      const int r = r0 + q * nw;
      if (r >= rend) continue;
      const int cond = r < NCTX ? 0 : 1 + ((r - NCTX) >> 11);
      const float* sh = MOD + ((size_t)l * 9 + cond) * 9216 + which * 3072;
      const float* sc = sh + 1024;
      const float rstd = rsqrtf(ss[q] * (1.f / 1024.f) + EPS);
#pragma unroll
      for (int i = 0; i < 4; ++i) {
        const int c = i * 256 + lane * 4;
        float4 gg = *(const float4*)(g + c), s4 = *(const float4*)(sc + c), h4 = *(const float4*)(sh + c);
        float y0 = v[q][i].x * rstd * gg.x * (1.f + s4.x) + h4.x;
        float y1 = v[q][i].y * rstd * gg.y * (1.f + s4.y) + h4.y;
        float y2 = v[q][i].z * rstd * gg.z * (1.f + s4.z) + h4.z;
        float y3 = v[q][i].w * rstd * gg.w * (1.f + s4.w) + h4.w;
        uint2 o; o.x = pack2(y0, y1); o.y = pack2(y2, y3);
        *(uint2*)(HB + (size_t)r * 1024 + c) = o;
      }
    }
  }
}

DI unsigned cvt_pk_bf16(float lo, float hi) { return pack2(lo, hi); }
namespace pg8 {
constexpr int BM = 256, BK = 64, HALF = 128, HTB = HALF * BK * 2, STAGE_BYTES = 8 * HTB, NXCD = 8, WGM = 8;
DI int lds_byte(int r, int c) { const int st = (r >> 4) * 2 + (c >> 5), rr = r & 15, cc = c & 31, ob = rr * 64 + cc * 2; return st * 1024 + (ob ^ (((ob >> 9) & 1) << 5)); }
DI void stage_rc(int b, int& R, int& C) { const int st = b / 1024, sb = b % 1024, swz = sb ^ (((sb >> 9) & 1) << 5); R = (st >> 1) * 16 + swz / 64; C = (st & 1) * 32 + (swz % 64) / 2; }
struct Unit { int pm, pn; };
struct Gemm { const u16* A; const u16* Bt; int M, N, K; };
struct StaticOrder {
  int nM, nN, nwg, G, c, panel;
  DI void init(int M, int N, int G_, int c_, int panel_ = 0) { nM = M / BM; nN = N / BM; nwg = nM * nN; G = G_; c = c_; panel = panel_; }
  DI int panel_of() const { const int xcd = c & 7, idx = c >> 3; return (idx >> 1) * 8 + xcd; }
  DI bool next(int i, Unit& u) const {
    if (panel) {
      const int pnl = panel_of();
      if (i >= 2 || pnl >= nM) return false;
      u.pm = pnl; u.pn = 2 * ((c >> 3) & 1) + i; return true;
    }
    const long L = (long)i * G + c; if (L >= nwg) return false;
    int wgid = (int)L; { const int q = nwg / NXCD, r = nwg % NXCD, xcd = wgid % NXCD, off = wgid / NXCD; wgid = (xcd < r ? xcd * (q + 1) : r * (q + 1) + (xcd - r) * q) + off; }
    const int nig = WGM * nN, gid = wgid / nig, fm = gid * WGM, gsz = (nM - fm) < WGM ? (nM - fm) : WGM;
    u.pm = fm + ((wgid % nig) % gsz); u.pn = (wgid % nig) / gsz; return true;
  }
};
enum { EPI_GU = 0, EPI_RESID = 1, EPI_BF16 = 2 };
struct Epi {
  int mode; u16* Cb; int ldc; float* X; const float* gvec; float coef;
  DI void operator()(const f32x4 (&acc)[2][2][4][2], const Unit& u, int wr, int wc, int fr, int fq) const {
    const int row0 = u.pm * BM + wr * 64 + fr, col0 = u.pn * BM + wc * 32 + 8 * fq;
    if (mode == EPI_GU) {
#pragma unroll
      for (int ai = 0; ai < 2; ++ai)
#pragma unroll
        for (int m = 0; m < 4; ++m) {
          u16* rowp = Cb + (size_t)(row0 + ai * HALF + m * 16) * ldc + u.pn * (BM / 2) + wc * 32 + 8 * fq;
          const f32x4 a0 = acc[ai][0][m][0], g0 = acc[ai][0][m][1], a1 = acc[ai][1][m][0], g1 = acc[ai][1][m][1];
          u32x4 o;
          o.x = cvt_pk_bf16(silu_f(a0[0]) * g0[0], silu_f(a0[1]) * g0[1]);
          o.y = cvt_pk_bf16(silu_f(a0[2]) * g0[2], silu_f(a0[3]) * g0[3]);
          o.z = cvt_pk_bf16(silu_f(a1[0]) * g1[0], silu_f(a1[1]) * g1[1]);
          o.w = cvt_pk_bf16(silu_f(a1[2]) * g1[2], silu_f(a1[3]) * g1[3]);
          *(u32x4*)rowp = o;
        }
    } else if (mode == EPI_RESID) {
      const int r0 = u.pm * BM;
      const int cond = r0 < NCTX ? 0 : 1 + ((r0 - NCTX) >> 11);
      const float* gv = gvec + (size_t)cond * 9216 + col0;
      f32x4 g4[2][2];
#pragma unroll
      for (int bj = 0; bj < 2; ++bj)
#pragma unroll
        for (int n = 0; n < 2; ++n) g4[bj][n] = *(const f32x4*)(gv + bj * HALF + n * 4) * coef;
#pragma unroll
      for (int ai = 0; ai < 2; ++ai)
#pragma unroll
        for (int m = 0; m < 4; ++m) {
          float* rowp = X + (size_t)(row0 + ai * HALF + m * 16) * 1024 + col0;
#pragma unroll
          for (int bj = 0; bj < 2; ++bj) {
            f32x4* xp = (f32x4*)(rowp + bj * HALF);
            const f32x4 x0 = xp[0], x1 = xp[1];
            xp[0] = x0 + g4[bj][0] * acc[ai][bj][m][0];
            xp[1] = x1 + g4[bj][1] * acc[ai][bj][m][1];
          }
        }
    } else {
#pragma unroll
      for (int ai = 0; ai < 2; ++ai)
#pragma unroll
        for (int m = 0; m < 4; ++m) {
          u16* rowp = Cb + (size_t)(row0 + ai * HALF + m * 16) * ldc + col0;
#pragma unroll
          for (int bj = 0; bj < 2; ++bj) {
            const f32x4 v0 = acc[ai][bj][m][0], v1 = acc[ai][bj][m][1];
            u32x4 o; o.x = cvt_pk_bf16(v0[0], v0[1]); o.y = cvt_pk_bf16(v0[2], v0[3]); o.z = cvt_pk_bf16(v1[0], v1[1]); o.w = cvt_pk_bf16(v1[2], v1[3]);
            *(u32x4*)(rowp + bj * HALF) = o;
          }
        }
    }
  }
};

DI void gemm_phase(LAS unsigned char* lds, const Gemm g, const StaticOrder& S, const Epi& E) {
  const int tid = TID(), wid = __builtin_amdgcn_readfirstlane(tid >> 6), lane = tid & 63, wr = wid >> 2, wc = wid & 3, fr = lane & 15, fq = lane >> 4;
  const int K = g.K, nt = K / BK;
  unsigned voffA[2];
#pragma unroll
  for (int i = 0; i < 2; ++i) { int R, C; stage_rc(tid * 16 + i * 8192, R, C); voffA[i] = (unsigned)(R * K + C) * 2u; }
  const size_t kstep = (size_t)(BK * 2);
  const size_t hstep = (size_t)HALF * K * 2;
  const size_t tstep = 2 * hstep;
  const unsigned ldsw = (unsigned)wid * 1024u;
  const int aoff = lds_byte(wr * 64 + fr, fq * 8), boff = lds_byte(wc * 32 + fr, fq * 8);
#define PG8_SA(b, h) (((b) * 2 + (h)) * HTB)
#define PG8_SB(b, h) ((4 + (b) * 2 + (h)) * HTB)
#define PG8_STAGE(bufoff, gbase) do { _Pragma("unroll") for (int _i = 0; _i < 2; ++_i) \
    __builtin_amdgcn_global_load_lds((const unsigned*)((const char*)(gbase) + voffA[_i]), (LAS unsigned*)(lds + (bufoff) + ldsw + _i * 8192), 16, 0, 0); } while (0)
#define PG8_LDA(dst, b, h) do { _Pragma("unroll") for (int m = 0; m < 4; ++m) _Pragma("unroll") for (int k = 0; k < 2; ++k) dst[m][k] = *(const LAS bf16x8*)(lds + PG8_SA(b, h) + aoff + m * 2048 + k * 1024); } while (0)
#define PG8_LDB(dst, b, h) do { _Pragma("unroll") for (int n = 0; n < 2; ++n) _Pragma("unroll") for (int k = 0; k < 2; ++k) dst[n][k] = *(const LAS bf16x8*)(lds + PG8_SB(b, h) + boff + n * 2048 + k * 1024); } while (0)
#define PG8_MMA(ai, bj, At, Bt) do { __builtin_amdgcn_s_setprio(1); _Pragma("unroll") for (int m = 0; m < 4; ++m) _Pragma("unroll") for (int n = 0; n < 2; ++n) _Pragma("unroll") for (int k = 0; k < 2; ++k) \
    acc[ai][bj][m][n] = __builtin_amdgcn_mfma_f32_16x16x32_bf16(Bt[n][k], At[m][k], acc[ai][bj][m][n], 0, 0, 0); __builtin_amdgcn_s_setprio(0); } while (0)
#define PG8_WAIT_V(n) asm volatile("s_waitcnt vmcnt(" #n ")" ::: "memory")
#define PG8_WAIT_L(n) asm volatile("s_waitcnt lgkmcnt(" #n ")" ::: "memory")
#define PG8_BAR __builtin_amdgcn_s_barrier()
#define PG8_SCHED __builtin_amdgcn_sched_barrier(0)
  Unit cur, nxt; int ui = 0;
  if (!S.next(0, cur)) return;
  f32x4 acc[2][2][4][2];
#pragma unroll
  for (int a = 0; a < 2; ++a)
#pragma unroll
    for (int b = 0; b < 2; ++b)
#pragma unroll
      for (int m = 0; m < 4; ++m)
#pragma unroll
        for (int n = 0; n < 2; ++n) acc[a][b][m][n] = (f32x4){0.f, 0.f, 0.f, 0.f};
  bf16x8 At[4][2], B0[2][2], B1[2][2];
  const char* cA = (const char*)g.A + (size_t)cur.pm * tstep; const char* cB = (const char*)g.Bt + (size_t)cur.pn * tstep;
  PG8_STAGE(PG8_SB(0, 0), cB); PG8_STAGE(PG8_SA(0, 0), cA); PG8_STAGE(PG8_SB(0, 1), cB + hstep); PG8_STAGE(PG8_SA(0, 1), cA + hstep);
  if (wr == 1) PG8_BAR;
  PG8_WAIT_V(4); PG8_BAR;
  PG8_STAGE(PG8_SB(1, 0), cB + kstep); PG8_STAGE(PG8_SA(1, 0), cA + kstep); PG8_STAGE(PG8_SB(1, 1), cB + hstep + kstep);
  PG8_WAIT_V(6); PG8_BAR;
  for (;;) {
    const bool has_next = S.next(ui + 1, nxt);
    const char* nA = has_next ? (const char*)g.A + (size_t)nxt.pm * tstep : cA; const char* nB = has_next ? (const char*)g.Bt + (size_t)nxt.pn * tstep : cB;
    for (int t = 0; t < nt; t += 2) {
      const bool last = (t == nt - 2);
      const char* a1 = cA + (size_t)(t + 1) * kstep;
      const char* a2 = last ? nA : cA + (size_t)(t + 2) * kstep; const char* b2 = last ? nB : cB + (size_t)(t + 2) * kstep;
      const char* a3 = a2 + kstep; const char* b3 = b2 + kstep;
      PG8_LDB(B0, 0, 0); PG8_SCHED; PG8_LDA(At, 0, 0); PG8_STAGE(PG8_SA(1, 1), a1 + hstep);
      PG8_WAIT_L(8); PG8_BAR; PG8_WAIT_L(0); PG8_MMA(0, 0, At, B0); PG8_BAR; PG8_SCHED;
      PG8_LDB(B1, 0, 1); PG8_STAGE(PG8_SB(0, 0), b2);
      PG8_BAR; PG8_WAIT_L(0); PG8_MMA(0, 1, At, B1); PG8_BAR;
      PG8_LDA(At, 0, 1); PG8_STAGE(PG8_SA(0, 0), a2);
      PG8_BAR; PG8_WAIT_L(0); PG8_MMA(1, 0, At, B0); PG8_BAR; PG8_SCHED;
      PG8_STAGE(PG8_SB(0, 1), b2 + hstep);
      PG8_WAIT_V(6); PG8_BAR; PG8_MMA(1, 1, At, B1); PG8_BAR;
      PG8_LDB(B0, 1, 0); PG8_SCHED; PG8_LDA(At, 1, 0); PG8_STAGE(PG8_SA(0, 1), a2 + hstep);
      PG8_WAIT_L(8); PG8_BAR; PG8_WAIT_L(0); PG8_MMA(0, 0, At, B0); PG8_BAR; PG8_SCHED;
      PG8_LDB(B1, 1, 1); PG8_STAGE(PG8_SB(1, 0), b3);
      PG8_BAR; PG8_WAIT_L(0); PG8_MMA(0, 1, At, B1); PG8_BAR;
      PG8_LDA(At, 1, 1); PG8_STAGE(PG8_SA(1, 0), a3);
      PG8_BAR; PG8_WAIT_L(0); PG8_MMA(1, 0, At, B0); PG8_BAR; PG8_SCHED;
      PG8_STAGE(PG8_SB(1, 1), b3 + hstep);
      PG8_WAIT_V(6); PG8_BAR; PG8_MMA(1, 1, At, B1); PG8_BAR;
    }
    E(acc, cur, wr, wc, fr, fq);
    if (!has_next) break;
#pragma unroll
    for (int a = 0; a < 2; ++a)
#pragma unroll
      for (int b = 0; b < 2; ++b)
#pragma unroll
        for (int m = 0; m < 4; ++m)
#pragma unroll
          for (int n = 0; n < 2; ++n) acc[a][b][m][n] = (f32x4){0.f, 0.f, 0.f, 0.f};
    cur = nxt; cA = nA; cB = nB; ++ui;
  }
  PG8_WAIT_V(0);
  if (wr == 0) PG8_BAR;
  PG8_BAR;
#undef PG8_SA
#undef PG8_SB
#undef PG8_STAGE
#undef PG8_LDA
#undef PG8_LDB
#undef PG8_MMA
#undef PG8_WAIT_V
#undef PG8_WAIT_L
#undef PG8_BAR
#undef PG8_SCHED
}
}

struct GemmJob { pg8::Gemm g; pg8::Epi e; };

DI void phase_gemm2(CParams& p, const GemmJob& g0, const GemmJob& g1, char* smem, int post_l, int post_which, int post_slot, int wl, int wjb, int wje) {
  LAS unsigned char* lds = (LAS unsigned char*)smem;
  pg8::StaticOrder S;
  const bool panel = post_slot >= 0;
  S.init(g0.g.M, g0.g.N, gridDim.x, BID(), panel ? 1 : 0);
  pg8::gemm_phase(lds, g0.g, S, g0.e);
  if (g1.g.M > 0) {
    __syncthreads();
    S.init(g1.g.M, g1.g.N, gridDim.x, BID());
    pg8::gemm_phase(lds, g1.g, S, g1.e);
  }
  __syncthreads();
  if (panel) {
    const int pnl = S.panel_of();
    if (pnl >= g0.g.M / 256) {
      if (wje > wjb) wprep_range(p, smem, wl, wjb, wje, (BID() >> 4) - 12 + 4 * (BID() & 7) + 32 * ((BID() >> 3) & 1), 64);
    }
    if (pnl < g0.g.M / 256) {
      unsigned* cnt = (unsigned*)(p.ws + WS_PCNT) + post_slot * 128 + pnl;
      asm volatile("s_waitcnt vmcnt(0)" ::: "memory");
      __syncthreads();
      if (threadIdx.x == 0) {
        __builtin_amdgcn_s_waitcnt(0);
        __builtin_amdgcn_fence(__ATOMIC_RELEASE, "agent");
        asm volatile("s_waitcnt vmcnt(0)" ::: "memory");
        xb_add(cnt, 1u);
        unsigned sp = 0;
        while (xb_ld(cnt) < 2u) { __builtin_amdgcn_s_sleep(1); if (++sp > XB_SPIN_CAP) break; }
        __builtin_amdgcn_fence(__ATOMIC_ACQUIRE, "agent");
        asm volatile("s_waitcnt vmcnt(0)" ::: "memory");
      }
      __syncthreads();
      if (post_l < 4) {
        const int half = (BID() >> 3) & 1;
        const int rb = pnl * 256 + half * 128;
        adaln_rows(p, post_l, post_which, rb + (TID() >> 6), NW, rb + 128);
      }
    }
  }
}

DI void tr_writeout(const u16* tile, int ldl, int C, int R, u16* dst, size_t dstride) {
  const int rq = R >> 3;
  for (int id = TID(); id < C * rq; id += NT) {
    const int q = id % rq, c = id / rq;
    const u16* tp = tile + (size_t)(8 * q) * ldl + c;
    u32x4 o;
    o.x = (unsigned)tp[0] | ((unsigned)tp[ldl] << 16);
    o.y = (unsigned)tp[2 * ldl] | ((unsigned)tp[3 * ldl] << 16);
    o.z = (unsigned)tp[4 * ldl] | ((unsigned)tp[5 * ldl] << 16);
    o.w = (unsigned)tp[6 * ldl] | ((unsigned)tp[7 * ldl] << 16);
    *(u32x4*)(dst + (size_t)c * dstride + 8 * q) = o;
  }
}

DI void phase_hyprep(CParams& p, int l, char* smem) {
  constexpr int LDL = 776, LDO = 770, LDV = 264;
  u16* tile = (u16*)smem;
  u16* outt = tile + 34 * LDL;
  u16* vtile = outt + 32 * LDO + 6;
  const u16* PROJ = (const u16*)(p.ws + WS_ACT);
  u16* HT = (u16*)(p.ws + WS_HT);
  u16* VTD = (u16*)(p.ws + WS_VTD);
  const float* wsh = p.in[I_HYSHORT] + (size_t)l * 3 * 768;
  const int tid = TID();
  vtile = (u16*)(smem + 106496);
  for (int tix = BID(); tix < MTOK / 32; tix += gridDim.x) {
    const int tok0 = tix * 32;
    const bool ctx = tok0 < NCTX;
    const int t0 = ctx ? (tok0 & 255) : ((tok0 - NCTX) & 2047), n = ctx ? 256 : 2048;
    const int seq = ctx ? (tok0 >> 8) : 32 + ((tok0 - NCTX) >> 11);
    const int nk = seq_nk(seq), key0 = ctx ? t0 : 512 + t0;
    __syncthreads();
    for (int id = tid; id < 34 * 96; id += NT) {
      const int r = id / 96, ch = id % 96;
      const int t = t0 + r - 1;
      u32x4 v = {0u, 0u, 0u, 0u};
      if (t >= 0 && t < n) v = *(const u32x4*)(PROJ + (size_t)(tok0 + r - 1) * INWP + 1696 + ch * 8);
      *(u32x4*)(tile + r * LDL + ch * 8) = v;
    }
    for (int id = tid; id < 32 * 32; id += NT) {
      const int r = id >> 5, ch = id & 31;
      *(u32x4*)(vtile + r * LDV + ch * 8) = *(const u32x4*)(PROJ + (size_t)(tok0 + r) * INWP + 2976 + ch * 8);
    }
    __syncthreads();
    tr_writeout(vtile, LDV, 256, 32, VTD + seq_kvb(seq) * 256 + key0, (size_t)nk);
    for (int id = tid; id < 768 * 4; id += NT) {
      const int q = id & 3, c = id >> 2;
      const u16* tp = tile + (8 * q) * LDL + c;
      const float w0 = wsh[c], w1 = wsh[768 + c], w2 = wsh[1536 + c];
      float x[10];
#pragma unroll
      for (int j = 0; j < 10; ++j) x[j] = bf2f(tp[j * LDL]);
      u32x4 o;
      o.x = pack2(w0 * x[0] + w1 * x[1] + w2 * x[2], w0 * x[1] + w1 * x[2] + w2 * x[3]);
      o.y = pack2(w0 * x[2] + w1 * x[3] + w2 * x[4], w0 * x[3] + w1 * x[4] + w2 * x[5]);
      o.z = pack2(w0 * x[4] + w1 * x[5] + w2 * x[6], w0 * x[5] + w1 * x[6] + w2 * x[7]);
      o.w = pack2(w0 * x[6] + w1 * x[7] + w2 * x[8], w0 * x[7] + w1 * x[8] + w2 * x[9]);
      *(u32x4*)(HT + (size_t)c * MTOK + tok0 + 8 * q) = o;
    }
  }
  for (int tix = BID(); tix < 128; tix += gridDim.x) {
    const int b = tix >> 4, tc0 = (tix & 15) * 32;
    __syncthreads();
    for (int id = tid; id < 32 * 64; id += NT) {
      const int r = id >> 6, c4 = id & 63;
      const float4 v = *(const float4*)(p.in[I_CDV] + (((size_t)b * 4 + l) * 512 + tc0 + r) * 256 + c4 * 4);
      uint2 o; o.x = pack2(v.x, v.y); o.y = pack2(v.z, v.w);
      *(uint2*)(vtile + r * LDV + c4 * 4) = o;
    }
    __syncthreads();
    tr_writeout(vtile, LDV, 256, 32, VTD + seq_kvb(32 + b) * 256 + tc0, (size_t)2560);
  }
}

DI void phase_vtm(CParams& p, char* smem) {
  constexpr int LDV = 264;
  u16* vtile = (u16*)smem;
  const u16* KVRAW = (const u16*)(p.ws + WS_KVRAW);
  u16* VTM = (u16*)(p.ws + WS_VTM);
  const int tid = TID();
  for (int tix = BID(); tix < NKV / 32; tix += gridDim.x) {
    const int kv0 = tix * 32;
    int seq, key0;
    if (kv0 < NCTX) { seq = kv0 >> 8; key0 = kv0 & 255; }
    else { const int rl = kv0 - NCTX; seq = 32 + rl / 2560; key0 = rl % 2560; }
    __syncthreads();
    for (int id = tid; id < 32 * 32; id += NT) {
      const int r = id >> 5, ch = id & 31;
      *(u32x4*)(vtile + r * LDV + ch * 8) = *(const u32x4*)(KVRAW + (size_t)(kv0 + r) * 512 + (ch >> 3) * 128 + 64 + (ch & 7) * 8);
    }
    __syncthreads();
    tr_writeout(vtile, LDV, 256, 32, VTM + seq_kvb(seq) * 256 + key0, (size_t)seq_nk(seq));
  }
}

DI void phase_hypost(CParams& p, char* smem) {
  constexpr int LDL = 264;
  u16* tile = (u16*)smem;
  const u16* HO = (const u16*)(p.ws + WS_HO);
  u16* OB = (u16*)(p.ws + WS_HB);
  const int tid = TID();
  for (int tix = BID(); tix < MTOK / 32; tix += gridDim.x) {
    const int tok0 = tix * 32;
    __syncthreads();
    for (int id = tid; id < 256 * 4; id += NT) {
      const int c = id >> 2, q = id & 3;
      const u32x4 v = *(const u32x4*)(HO + (size_t)c * MTOK + tok0 + q * 8);
      u16* tp = tile + (q * 8) * LDL + c;
      tp[0] = (u16)(v.x & 0xffff); tp[LDL] = (u16)(v.x >> 16);
      tp[2 * LDL] = (u16)(v.y & 0xffff); tp[3 * LDL] = (u16)(v.y >> 16);
      tp[4 * LDL] = (u16)(v.z & 0xffff); tp[5 * LDL] = (u16)(v.z >> 16);
      tp[6 * LDL] = (u16)(v.w & 0xffff); tp[7 * LDL] = (u16)(v.w >> 16);
    }
    __syncthreads();
    for (int id = tid; id < 32 * 32; id += NT) {
      const int tok = id >> 5, cq = id & 31;
      *(u32x4*)(OB + (size_t)(tok0 + tok) * 1024 + 512 + cq * 8) = *(const u32x4*)(tile + tok * LDL + cq * 8);
    }
  }
}

DI void phase_prep1(CParams& p, int l) {
  const int lane = TID() & 63;
  const int gw = BID() * NW + (TID() >> 6), nw = gridDim.x * NW;
  const u16* PROJ = (const u16*)(p.ws + WS_ACT);
  u16* CQ = (u16*)(p.ws + WS_CQ);
  u16* CKV = (u16*)(p.ws + WS_CKV);
  u16* QD = (u16*)(p.ws + WS_QD);
  u16* KD = (u16*)(p.ws + WS_KD);
  u16* VTD = (u16*)(p.ws + WS_VTD);
  const float* ROPE = (const float*)(p.ws + WS_ROPE);
  const float scaleq = 0.17677669529663687f * LOG2E;
  struct TokRaw { uint2 cq, dq, dk, dv; unsigned ckv, kr; float cs[4], sn[4]; };
  auto tok_load = [&](int r) {
    TokRaw w;
    const u16* pr = PROJ + (size_t)r * INWP;
    w.cq = *(const uint2*)(pr + 1280 + lane * 4);
    w.ckv = *(const unsigned*)(pr + 1536 + lane * 2);
    w.kr = pr[1664 + (lane & 31)];
    w.dq = *(const uint2*)(pr + 2464 + lane * 4);
    w.dk = *(const uint2*)(pr + 2720 + lane * 4);
    w.dv = *(const uint2*)(pr + 2976 + lane * 4);
    const int t = r < NCTX ? 0 : ((r - NCTX) & 2047);
#pragma unroll
    for (int i = 0; i < 4; ++i) {
      const int ti = ((lane & 4) ? 8 : 0) + (lane & 1) * 4 + i;
      w.cs[i] = ROPE[t * 32 + ti]; w.sn[i] = ROPE[t * 32 + 16 + ti];
    }
    return w;
  };
  auto tok_proc = [&](int r, const TokRaw& w) {
    const bool ctx = r < NCTX;
    int b, t;
    if (ctx) { b = r >> 8; t = r & 255; } else { int rl = r - NCTX; b = rl >> 11; t = rl & 2047; }
    const int seq = ctx ? b : 32 + b, nk = ctx ? 256 : 2560, key = ctx ? t : 512 + t;
    const size_t kvb = seq_kvb(seq);
    const size_t orow = ((size_t)b * 4 + l) * 256 + t;
    {
      float v0 = bflo(w.cq.x), v1 = bfhi(w.cq.x), v2 = bflo(w.cq.y), v3 = bfhi(w.cq.y);
      float ss = wave_sum(v0 * v0 + v1 * v1 + v2 * v2 + v3 * v3);
      float rstd = rsqrtf(ss * (1.f / 256.f) + EPS);
      const float* g = p.in[I_QNORM] + l * 256 + lane * 4;
      uint2 o; o.x = pack2(v0 * rstd * g[0], v1 * rstd * g[1]); o.y = pack2(v2 * rstd * g[2], v3 * rstd * g[3]);
      *(uint2*)(CQ + (size_t)r * 256 + lane * 4) = o;
    }
    {
      float v0 = bflo(w.ckv), v1 = bfhi(w.ckv);
      float ss = wave_sum(v0 * v0 + v1 * v1);
      float rstd = rsqrtf(ss * (1.f / 128.f) + EPS);
      const float* g = p.in[I_KVNORM] + l * 128 + lane * 2;
      float c0 = v0 * rstd * g[0], c1 = v1 * rstd * g[1];
      *(unsigned*)(CKV + (kvb + key) * 256 + lane * 2) = pack2(c0, c1);
      *(unsigned*)(CKV + (kvb + key) * 256 + 128 + lane * 2) = 0u;
      if (ctx) {
        float* om = p.out + O_MLA + orow * 160;
        *(float2*)(om + lane * 2) = float2{c0, c1};
        if (lane < 32) om[128 + lane] = bf2f((u16)w.kr);
      }
    }
#pragma unroll
    for (int which = 0; which < 2; ++which) {
      const uint2 raw = which ? w.dk : w.dq;
      float y[4] = {bflo(raw.x), bfhi(raw.x), bflo(raw.y), bfhi(raw.y)};
      float ss = y[0] * y[0] + y[1] * y[1] + y[2] * y[2] + y[3] * y[3];
      ss += __shfl_xor(ss, 1); ss += __shfl_xor(ss, 2); ss += __shfl_xor(ss, 4);
      const float rstd = rsqrtf(ss * (1.f / 32.f) + EPS);
      const int d0 = (lane & 7) * 4;
      const float* g = p.in[I_DQKNORM] + (l * 2 + which) * 32 + d0;
#pragma unroll
      for (int i = 0; i < 4; ++i) y[i] = y[i] * rstd * g[i];
      if (which == 1 && ctx) *(float4*)(p.out + O_DK + orow * 256 + lane * 4) = float4{y[0], y[1], y[2], y[3]};
      if (!ctx) {
#pragma unroll
        for (int i = 0; i < 4; ++i) {
          float pv = __shfl_xor(y[i], 2);
          y[i] = (lane & 2) ? (pv * w.sn[i] + y[i] * w.cs[i]) : (y[i] * w.cs[i] - pv * w.sn[i]);
        }
      }
      if (which == 0) {
        uint2 o; o.x = pack2(y[0] * scaleq, y[1] * scaleq); o.y = pack2(y[2] * scaleq, y[3] * scaleq);
        *(uint2*)(QD + (size_t)r * 256 + lane * 4) = o;
      } else {
        uint2 o; o.x = pack2(y[0], y[1]); o.y = pack2(y[2], y[3]);
        *(uint2*)(KD + kvb * 256 + ((size_t)(lane >> 3) * nk + key) * 32 + d0) = o;
      }
    }
    if (ctx) *(float4*)(p.out + O_DV + orow * 256 + lane * 4) = float4{bflo(w.dv.x), bfhi(w.dv.x), bflo(w.dv.y), bfhi(w.dv.y)};
  };
  for (int it = gw; it < MTOK; it += 2 * nw) {
    const int r0 = it, r1 = it + nw;
    const bool has1 = r1 < MTOK;
    const TokRaw w0 = tok_load(r0);
    const TokRaw w1 = tok_load(has1 ? r1 : r0);
    tok_proc(r0, w0);
    if (has1) tok_proc(r1, w1);
  }
  for (int j = gw; j < 4096; j += nw) {
    const int b = j >> 9, tc = j & 511;
    const size_t kvb = seq_kvb(32 + b);
    const int nk = 2560;
    const size_t crow = ((size_t)b * 4 + l) * 512 + tc;
    {
      float2 v = *(const float2*)(p.in[I_CMLA] + crow * 160 + lane * 2);
      *(unsigned*)(CKV + (kvb + tc) * 256 + lane * 2) = pack2(v.x, v.y);
      *(unsigned*)(CKV + (kvb + tc) * 256 + 128 + lane * 2) = 0u;
    }
    {
      float4 v = *(const float4*)(p.in[I_CDK] + crow * 256 + lane * 4);
      uint2 o; o.x = pack2(v.x, v.y); o.y = pack2(v.z, v.w);
      *(uint2*)(KD + kvb * 256 + ((size_t)(lane >> 3) * nk + tc) * 32 + (lane & 7) * 4) = o;
    }
  }
}

DI void phase_prep2(CParams& p, int l) {
  const int lane = TID() & 63, hh = lane >> 4, e = lane & 15;
  const int gw = BID() * NW + (TID() >> 6), nw = gridDim.x * NW;
  const u16* PROJ = (const u16*)(p.ws + WS_ACT);
  const u16* QRAW = (const u16*)(p.ws + WS_QRAW);
  const u16* KVRAW = (const u16*)(p.ws + WS_KVRAW);
  u16* QM = (u16*)(p.ws + WS_QM);
  u16* KM = (u16*)(p.ws + WS_KM);
  u16* VTM = (u16*)(p.ws + WS_VTM);
  const float* ROPE = (const float*)(p.ws + WS_ROPE);
  const float scalem = 0.10206207261596577f * LOG2E;
  for (int it = gw; it < MTOK + NKV; it += nw) {
    if (it < MTOK) {
      const int r = it;
      const bool ctx = r < NCTX;
      const int t = ctx ? (r & 255) : ((r - NCTX) & 2047);
      const u16* src = QRAW + (size_t)r * 512 + hh * 96;
      float y[6];
      float ss = 0.f;
#pragma unroll
      for (int i = 0; i < 6; ++i) { y[i] = bf2f(src[e + 16 * i]); ss += y[i] * y[i]; }
      ss += __shfl_xor(ss, 1); ss += __shfl_xor(ss, 2); ss += __shfl_xor(ss, 4); ss += __shfl_xor(ss, 8);
      const float rstd = rsqrtf(ss * (1.f / 96.f) + EPS);
      const float* g = p.in[I_QKNORM] + (l * 2 + 0) * 96;
#pragma unroll
      for (int i = 0; i < 6; ++i) y[i] = y[i] * rstd * g[e + 16 * i];
      if (!ctx) {
#pragma unroll
        for (int i = 4; i < 6; ++i) {
          float pv = __shfl_xor(y[i], 8);
          const int ti = (i == 5 ? 8 : 0) + (e & 7);
          const float cs = ROPE[t * 32 + ti], sn = ROPE[t * 32 + 16 + ti];
          y[i] = (e & 8) ? (pv * sn + y[i] * cs) : (y[i] * cs - pv * sn);
        }
      }
      u16* dst = QM + (size_t)r * 384 + hh * 96;
#pragma unroll
      for (int i = 0; i < 6; ++i) dst[e + 16 * i] = f2bf(y[i] * scalem);
    } else {
      const int kvrow = it - MTOK;
      int seq, key, t = 0;
      bool rope = false;
      const u16* kr_bf = nullptr;
      const float* kr_f = nullptr;
      if (kvrow < NCTX) {
        seq = kvrow >> 8; key = kvrow & 255;
        kr_bf = PROJ + (size_t)kvrow * INWP + 1664;
      } else {
        const int rl = kvrow - NCTX, b = rl / 2560;
        key = rl - b * 2560; seq = 32 + b;
        if (key < 512) kr_f = p.in[I_CMLA] + (((size_t)b * 4 + l) * 512 + key) * 160 + 128;
        else { t = key - 512; rope = true; kr_bf = PROJ + (size_t)(NCTX + b * 2048 + t) * INWP + 1664; }
      }
      const int nk = seq_nk(seq);
      const size_t kvb = seq_kvb(seq);
      const u16* src = KVRAW + (size_t)kvrow * 512 + hh * 128;
      float y[6];
      float ss = 0.f;
#pragma unroll
      for (int i = 0; i < 4; ++i) y[i] = bf2f(src[e + 16 * i]);
#pragma unroll
      for (int i = 4; i < 6; ++i) y[i] = kr_bf ? bf2f(kr_bf[e + 16 * (i - 4)]) : kr_f[e + 16 * (i - 4)];
#pragma unroll
      for (int i = 0; i < 6; ++i) ss += y[i] * y[i];
      ss += __shfl_xor(ss, 1); ss += __shfl_xor(ss, 2); ss += __shfl_xor(ss, 4); ss += __shfl_xor(ss, 8);
      const float rstd = rsqrtf(ss * (1.f / 96.f) + EPS);
      const float* g = p.in[I_QKNORM] + (l * 2 + 1) * 96;
#pragma unroll
      for (int i = 0; i < 6; ++i) y[i] = y[i] * rstd * g[e + 16 * i];
      if (rope) {
#pragma unroll
        for (int i = 4; i < 6; ++i) {
          float pv = __shfl_xor(y[i], 8);
          const int ti = (i == 5 ? 8 : 0) + (e & 7);
          const float cs = ROPE[t * 32 + ti], sn = ROPE[t * 32 + 16 + ti];
          y[i] = (e & 8) ? (pv * sn + y[i] * cs) : (y[i] * cs - pv * sn);
        }
      }
      u16* dst = KM + kvb * 384 + ((size_t)hh * nk + key) * 96;
#pragma unroll
      for (int i = 0; i < 6; ++i) dst[e + 16 * i] = f2bf(y[i]);
    }
  }
}

DI int crow(int i, int h) { return (i & 3) + 8 * (i >> 2) + 4 * h; }

template <int DQK, int NMAP>
DI void attn_wave(CParams& p, int l, const u16* __restrict__ Q, int qstride, int qmapstride,
                  const u16* __restrict__ K, size_t kmapstride, const u16* __restrict__ Vt, int nk, int orow0, int ocol0, char* smem) {
  constexpr int NS = DQK / 16, LDK = DQK + 8, LDV = 72;
  constexpr int KCH = NMAP * 64 * DQK / 8;
  constexpr int KSZ = NMAP * 64 * LDK, STG = KSZ + 64 * LDV;
  u16* lds = (u16*)smem;
  const int tid = TID(), lane = tid & 63, r = lane & 31, h = lane >> 5;
  bf16x8 bq[NMAP][NS];
#pragma unroll
  for (int m = 0; m < NMAP; ++m)
#pragma unroll
    for (int s = 0; s < NS; ++s) bq[m][s] = *(const bf16x8*)(Q + (size_t)r * qstride + m * qmapstride + 16 * s + 8 * h);
  f32x16 O[NMAP][2];
  float mrun[NMAP], lsum[NMAP];
#pragma unroll
  for (int m = 0; m < NMAP; ++m) {
    mrun[m] = 0.f; lsum[m] = 0.f;
#pragma unroll
    for (int mt = 0; mt < 2; ++mt)
#pragma unroll
      for (int i = 0; i < 16; ++i) O[m][mt][i] = 0.f;
  }
  u32x4 rk0, rk1, rv;
  const int kc0 = tid, kc1 = tid + NT;
  constexpr int CPK = DQK / 8;
  const int k0m = kc0 / (64 * CPK), k0key = (kc0 / CPK) % 64, k0c = kc0 % CPK;
  const int k1m = kc1 / (64 * CPK), k1key = (kc1 / CPK) % 64, k1c = kc1 % CPK;
  const u16* gk0 = K + k0m * kmapstride + (size_t)k0key * DQK + k0c * 8;
  const u16* gk1 = K + k1m * kmapstride + (size_t)k1key * DQK + k1c * 8;
  const int lk0 = (k0m * 64 + k0key) * LDK + k0c * 8, lk1 = (k1m * 64 + k1key) * LDK + k1c * 8;
  const int vdv = tid >> 3, vq = tid & 7;
  const u16* gv = Vt + (size_t)vdv * nk + vq * 8;
  const int lv = KSZ + vdv * LDV + vq * 8;
#define ATTN_GLOAD(K0)                                                      \
  {                                                                         \
    rk0 = *(const u32x4*)(gk0 + (size_t)(K0) * DQK);                        \
    if (KCH > NT && kc1 < KCH) rk1 = *(const u32x4*)(gk1 + (size_t)(K0) * DQK); \
    rv = *(const u32x4*)(gv + (K0));                                        \
  }
  ATTN_GLOAD(0)
  __syncthreads();
  const int ntile = nk >> 6;
  for (int t = 0; t < ntile; ++t) {
    u16* st = lds + (t & 1) * STG;
    *(u32x4*)(st + lk0) = rk0;
    if (KCH > NT && kc1 < KCH) *(u32x4*)(st + lk1) = rk1;
    *(u32x4*)(st + lv) = rv;
    __syncthreads();
    if (t + 1 < ntile) ATTN_GLOAD((t + 1) * 64)
    f32x16 accs[2][NMAP];
#pragma unroll
    for (int sub = 0; sub < 2; ++sub)
#pragma unroll
      for (int m = 0; m < NMAP; ++m) {
#pragma unroll
        for (int i = 0; i < 16; ++i) accs[sub][m][i] = -mrun[m];
        const u16* kp = st + (m * 64 + sub * 32 + r) * LDK + 8 * h;
#pragma unroll
        for (int s = 0; s < NS; ++s) {
          const bf16x8 ak = *(const bf16x8*)(kp + 16 * s);
          accs[sub][m] = __builtin_amdgcn_mfma_f32_32x32x16_bf16(ak, bq[m][s], accs[sub][m], 0, 0, 0);
        }
      }
#pragma unroll
    for (int sub = 0; sub < 2; ++sub) {
      bf16x8 av[2][2];
#pragma unroll
      for (int mt = 0; mt < 2; ++mt)
#pragma unroll
        for (int s2 = 0; s2 < 2; ++s2) {
          const u16* vp = st + KSZ + (mt * 32 + r) * LDV + sub * 32 + 16 * s2 + 4 * h;
          bf16x4 lo = *(const bf16x4*)vp, hi = *(const bf16x4*)(vp + 8);
          av[mt][s2] = __builtin_shufflevector(lo, hi, 0, 1, 2, 3, 4, 5, 6, 7);
        }
#pragma unroll
      for (int m = 0; m < NMAP; ++m) {
        f32x16& acc = accs[sub][m];
        float mx = fmaxf(acc[0], acc[1]);
#pragma unroll
        for (int i = 2; i < 16; i += 2) mx = fmaxf(mx, fmaxf(acc[i], acc[i + 1]));
        const bool first = (t == 0 && sub == 0);
        if (first || __builtin_amdgcn_ballot_w64(mx > 8.f) != 0ull) {
          const float mp = fmaxf(mx, __shfl_xor(mx, 32));
          const float d = first ? mp : fmaxf(mp, 0.f);
          const float alpha = first ? 1.f : __builtin_amdgcn_exp2f(-d);
          mrun[m] += d;
          lsum[m] *= alpha;
#pragma unroll
          for (int mt = 0; mt < 2; ++mt)
#pragma unroll
            for (int i = 0; i < 16; ++i) O[m][mt][i] *= alpha;
#pragma unroll
          for (int i = 0; i < 16; ++i) acc[i] -= d;
          if (sub == 0) {
#pragma unroll
            for (int i = 0; i < 16; ++i) accs[1][m][i] -= d;
          }
        }
        float ps = 0.f;
#pragma unroll
        for (int i = 0; i < 16; ++i) { acc[i] = __builtin_amdgcn_exp2f(acc[i]); ps += acc[i]; }
        lsum[m] += ps;
        bf16x8 pf[2];
#pragma unroll
        for (int s2 = 0; s2 < 2; ++s2) {
          u32x4 pk;
          pk.x = pack2(acc[8 * s2 + 0], acc[8 * s2 + 1]); pk.y = pack2(acc[8 * s2 + 2], acc[8 * s2 + 3]);
          pk.z = pack2(acc[8 * s2 + 4], acc[8 * s2 + 5]); pk.w = pack2(acc[8 * s2 + 6], acc[8 * s2 + 7]);
          pf[s2] = __builtin_bit_cast(bf16x8, pk);
        }
#pragma unroll
        for (int mt = 0; mt < 2; ++mt)
#pragma unroll
          for (int s2 = 0; s2 < 2; ++s2)
            O[m][mt] = __builtin_amdgcn_mfma_f32_32x32x16_bf16(av[mt][s2], pf[s2], O[m][mt], 0, 0, 0);
      }
    }
  }
#undef ATTN_GLOAD
  u16* OB = (u16*)(p.ws + WS_HB);
  u16* op = OB + (size_t)(orow0 + r) * 1024 + ocol0;
  if (NMAP == 1) {
    const float inv = 1.f / (lsum[0] + __shfl_xor(lsum[0], 32));
#pragma unroll
    for (int mt = 0; mt < 2; ++mt)
#pragma unroll
      for (int g = 0; g < 4; ++g) {
        uint2 o;
        o.x = pack2(O[0][mt][4 * g] * inv, O[0][mt][4 * g + 1] * inv);
        o.y = pack2(O[0][mt][4 * g + 2] * inv, O[0][mt][4 * g + 3] * inv);
        *(uint2*)(op + mt * 32 + 8 * g + 4 * h) = o;
      }
  } else {
    const float* dl = p.in[I_DLAM] + l * 128;
    float a = 0.f, b = 0.f;
    if (lane < 32) { a = dl[lane] * dl[32 + lane]; b = dl[64 + lane] * dl[96 + lane]; }
    a = wave_sum(a); b = wave_sum(b);
    const float lam_init = 0.8f - 0.6f * expf(-0.3f * (float)l);
    const float lam = expf(a) - expf(b) + lam_init;
    const float inv0 = 1.f / (lsum[0] + __shfl_xor(lsum[0], 32));
    const float inv1 = lam / (lsum[NMAP - 1] + __shfl_xor(lsum[NMAP - 1], 32));
    float ss = 0.f;
#pragma unroll
    for (int mt = 0; mt < 2; ++mt)
#pragma unroll
      for (int i = 0; i < 16; ++i) {
        float o = O[0][mt][i] * inv0 - O[NMAP - 1][mt][i] * inv1;
        O[0][mt][i] = o;
        ss += o * o;
      }
    ss += __shfl_xor(ss, 32);
    const float rstd = rsqrtf(ss * (1.f / 64.f) + EPS) * (1.f - lam_init);
    const float* sg = p.in[I_DSUBLN] + l * 64;
#pragma unroll
    for (int mt = 0; mt < 2; ++mt)
#pragma unroll
      for (int g = 0; g < 4; ++g) {
        const int dv = mt * 32 + 8 * g + 4 * h;
        uint2 o;
        o.x = pack2(O[0][mt][4 * g] * rstd * sg[dv], O[0][mt][4 * g + 1] * rstd * sg[dv + 1]);
        o.y = pack2(O[0][mt][4 * g + 2] * rstd * sg[dv + 2], O[0][mt][4 * g + 3] * rstd * sg[dv + 3]);
        *(uint2*)(op + dv) = o;
      }
  }
}

DI void mla_item(CParams& p, int l, int seq, int head, int qb, char* smem) {
  const int w = TID() >> 6;
  const int nk = seq_nk(seq), row0 = seq_row0(seq), q0 = qb * 256 + w * 32;
  const size_t kvb = seq_kvb(seq);
  const u16* Q = (const u16*)(p.ws + WS_QM) + (size_t)(row0 + q0) * 384 + head * 96;
  const u16* K = (const u16*)(p.ws + WS_KM) + kvb * 384 + (size_t)head * nk * 96;
  const u16* Vt = (const u16*)(p.ws + WS_VTM) + kvb * 256 + (size_t)head * 64 * nk;
  attn_wave<96, 1>(p, l, Q, 384, 0, K, 0, Vt, nk, row0 + q0, 256 + head * 64, smem);
}
DI void diff_item(CParams& p, int l, int seq, int head, int qb, char* smem) {
  const int w = TID() >> 6;
  const int nk = seq_nk(seq), row0 = seq_row0(seq), q0 = qb * 256 + w * 32;
  const size_t kvb = seq_kvb(seq);
  const u16* Q = (const u16*)(p.ws + WS_QD) + (size_t)(row0 + q0) * 256 + head * 64;
  const u16* K = (const u16*)(p.ws + WS_KD) + kvb * 256 + (size_t)(head * 2) * nk * 32;
  const u16* Vt = (const u16*)(p.ws + WS_VTD) + kvb * 256 + (size_t)head * 64 * nk;
  attn_wave<32, 2>(p, l, Q, 256, 32, K, (size_t)nk * 32, Vt, nk, row0 + q0, 768 + head * 64, smem);
}

DI float dpp_add(float x, float acc_src, int) { return x + acc_src; }
#define DPP_F(x, ctrl) __builtin_bit_cast(float, __builtin_amdgcn_update_dpp(0, __builtin_bit_cast(int, (x)), (ctrl), 0xF, 0xF, false))
DI float red16(float o) {
  o += DPP_F(o, 0xB1);
  o += DPP_F(o, 0x4E);
  o += DPP_F(o, 0x141);
  o += DPP_F(o, 0x140);
  return o;
}
DI float red8(float o) {
  o += DPP_F(o, 0xB1);
  o += DPP_F(o, 0x4E);
  o += DPP_F(o, 0x141);
  return o;
}
DI void hgrn_item(CParams& p, int l, int seq, int head, int dir, char* smem) {
  constexpr int CH = 128;
  float* qs = (float*)smem;
  float* ks = qs + CH * 64;
  float* vs = ks + CH * 64;
  const int tid = TID(), v = tid >> 3, kq = tid & 7, e = tid & 63;
  const int L = seq_nq(seq), row0 = seq_row0(seq);
  const bool ctx = seq < 32;
  const int b = ctx ? seq : seq - 32;
  const u16* PROJ = (const u16*)(p.ws + WS_ACT);
  float* OUTB = (float*)(p.ws + (dir ? WS_OBW : WS_OF));
  float oml;
  {
    const float* lg = p.in[I_LB] + (size_t)dir * 1024 + head * 64 + e;
    float l0 = lg[0], l1 = lg[256], l2 = lg[512], l3 = lg[768];
    float mx = fmaxf(fmaxf(l0, l1), fmaxf(l2, l3));
    float e0 = expf(l0 - mx), e1 = expf(l1 - mx), e2 = expf(l2 - mx), e3 = expf(l3 - mx);
    float tot = e0 + e1 + e2 + e3;
    float lb = ((l >= 1 ? e1 : 0.f) + (l >= 2 ? e2 : 0.f) + (l >= 3 ? e3 : 0.f)) / tot;
    oml = 1.f - lb;
  }
  f32x2v S[4];
  const size_t sbase = ((((size_t)b * 4 + l) * 2 + dir) * 4 + head) * 4096;
  {
    const float* sp = p.in[I_SHG] + sbase + (size_t)(kq * 8) * 64 + v;
#pragma unroll
    for (int i = 0; i < 4; ++i) { S[i].x = ctx ? 0.f : sp[(2 * i) * 64]; S[i].y = ctx ? 0.f : sp[(2 * i + 1) * 64]; }
  }
  const int foff = dir ? 768 : 512;
  u16 rq[16], ri[16], rf[16];
#define HGRN_FETCH(N0)                                                              \
  _Pragma("unroll") for (int i4 = 0; i4 < 16; ++i4) {                                \
    const int idx = tid + i4 * NT, tt = idx >> 6, n = (N0) + tt, t = dir ? L - 1 - n : n; \
    const u16* pr = PROJ + (size_t)(row0 + t) * INWP + head * 64 + e;               \
    rq[i4] = pr[0]; ri[i4] = pr[256]; rf[i4] = pr[foff];                            \
  }
  HGRN_FETCH(0)
  for (int n0 = 0; n0 < L; n0 += CH) {
    __syncthreads();
#pragma unroll
    for (int i4 = 0; i4 < 16; ++i4) {
      const int idx = tid + i4 * NT;
      qs[idx] = silu_f(bf2f(rq[i4])) * 0.125f;
      vs[idx] = bf2f(ri[i4]);
      ks[idx] = fminf(oml * sigm_f(-bf2f(rf[i4])), MAXK);
    }
    __syncthreads();
    if (n0 + CH < L) { HGRN_FETCH(n0 + CH) }
    float vt = vs[v];
    f32x4 ka = *(const f32x4*)&ks[kq * 8], kb = *(const f32x4*)&ks[kq * 8 + 4];
    f32x4 qa = *(const f32x4*)&qs[kq * 8], qb = *(const f32x4*)&qs[kq * 8 + 4];
    for (int t8 = 0; t8 < CH; t8 += 8) {
      float keep = 0.f;
#pragma unroll
      for (int uu = 0; uu < 8; ++uu) {
        const int tt = t8 + uu;
        const int t1 = tt + 1 < CH ? tt + 1 : CH - 1;
        const float vtn = vs[t1 * 64 + v];
        const f32x4 kan = *(const f32x4*)&ks[t1 * 64 + kq * 8], kbn = *(const f32x4*)&ks[t1 * 64 + kq * 8 + 4];
        const f32x4 qan = *(const f32x4*)&qs[t1 * 64 + kq * 8], qbn = *(const f32x4*)&qs[t1 * 64 + kq * 8 + 4];
        const f32x2v vv2 = {vt, vt};
        const f32x2v k2[4] = {{ka[0], ka[1]}, {ka[2], ka[3]}, {kb[0], kb[1]}, {kb[2], kb[3]}};
        const f32x2v q2[4] = {{qa[0], qa[1]}, {qa[2], qa[3]}, {qb[0], qb[1]}, {qb[2], qb[3]}};
        f32x2v o2 = {0.f, 0.f};
#pragma unroll
        for (int i = 0; i < 4; ++i) {
          S[i] = __builtin_elementwise_fma(k2[i], vv2 - S[i], S[i]);
          o2 = __builtin_elementwise_fma(S[i], q2[i], o2);
        }
        const float o = red8(o2.x + o2.y);
        keep = (kq == uu) ? o : keep;
        vt = vtn; ka = kan; kb = kbn; qa = qan; qb = qbn;
      }
      {
        const int n = n0 + t8 + kq, t = dir ? L - 1 - n : n;
        OUTB[(size_t)(row0 + t) * 256 + head * 64 + v] = keep;
      }
    }
  }
  if (ctx) {
    float* sp = p.out + O_HG + sbase + (size_t)(kq * 8) * 64 + v;
#pragma unroll
    for (int i = 0; i < 4; ++i) { sp[(2 * i) * 64] = S[i].x; sp[(2 * i + 1) * 64] = S[i].y; }
  }
}

#undef HGRN_FETCH
template <int N, int NB>
DI void hyena_item(CParams& p, int l, int seq0, int ch, char* smem) {
  constexpr int T = N / 32, LDU = N + 8, NBG = NB / 8, NTILES = NBG * (T / 4), TPW = NTILES / NW, LDR = 2 * N + 8;
  u16* U = (u16*)smem;
  u16* Z = U + NB * LDU;
  u16* RC = Z + NB * LDU;
  u16* R = RC + 8 * LDR;
  const int tid = TID(), lane = tid & 63, w = tid >> 6, r = lane & 31, h = lane >> 5;
  const u16* HT = (const u16*)(p.ws + WS_HT);
  u16* HO = (u16*)(p.ws + WS_HO);
  const float* FB = filt_ptr(p, l, N == 2048 ? 1 : 0);
  const float bias[2] = {p.in[I_HYBIAS][(l * 2 + 0) * 256 + ch], p.in[I_HYBIAS][(l * 2 + 1) * 256 + ch]};
  __syncthreads();
  for (int id = tid; id < NB * (N / 8); id += NT) {
    const int b = id / (N / 8), q = id % (N / 8);
    *(u32x4*)(U + b * LDU + q * 8) = *(const u32x4*)(HT + (size_t)ch * MTOK + (size_t)seq_row0(seq0 + b) + q * 8);
  }
#pragma unroll
  for (int order = 0; order < 2; ++order) {
    const float* G = FB + (size_t)(order * 256 + ch) * 2 * N;
    for (int x = tid; x < 2 * N + 16; x += NT) R[x] = x < 2 * N ? f2bf(G[2 * N - 1 - x]) : (u16)0;
    __syncthreads();
    for (int id = tid; id < 8 * (LDR / 8); id += NT) {
      const int rho = id / (LDR / 8), a8 = (id % (LDR / 8)) * 8;
      const u16* rp = R + a8 + rho;
      u32x4 o;
      o.x = (unsigned)rp[0] | ((unsigned)rp[1] << 16); o.y = (unsigned)rp[2] | ((unsigned)rp[3] << 16);
      o.z = (unsigned)rp[4] | ((unsigned)rp[5] << 16); o.w = (unsigned)rp[6] | ((unsigned)rp[7] << 16);
      *(u32x4*)(RC + rho * LDR + a8) = o;
    }
    __syncthreads();
    const u16* SRC = order == 0 ? U : Z;
    u16* DST = order == 0 ? Z : U;
    const u16* XG = HT + (size_t)((order + 1) * 256 + ch) * MTOK;
    int tau[TPW], bb[TPW];
    f32x16 acc[TPW];
#pragma unroll
    for (int tw = 0; tw < TPW; ++tw) {
      const int nt = w * TPW + tw, bg = nt % NBG, tg = nt / NBG;
      tau[tw] = 4 * tg + (r >> 3); bb[tw] = 8 * bg + (r & 7);
#pragma unroll
      for (int i = 0; i < 16; ++i) acc[tw][i] = 0.f;
    }
    const int tg_lo = (w * TPW) / NBG, tg_hi = (w * TPW + TPW - 1) / NBG;
    uint2 xpre[TPW][4];
#pragma unroll
    for (int tw = 0; tw < TPW; ++tw) {
      const size_t grow = (size_t)seq_row0(seq0 + bb[tw]);
#pragma unroll
      for (int g4 = 0; g4 < 4; ++g4) xpre[tw][g4] = *(const uint2*)(XG + grow + 32 * tau[tw] + 8 * g4 + 4 * h);
    }
    for (int delta = 4 * tg_lo - (T - 1); delta <= 4 * tg_hi + 3; ++delta) {
      const int x0 = N - 1 - 32 * delta - r + 8 * h;
#pragma unroll
      for (int s2 = 0; s2 < 2; ++s2) {
        const int xx = x0 + 16 * s2;
        const bf16x8 af = *(const bf16x8*)(RC + (xx & 7) * LDR + (xx & ~7));
#pragma unroll
        for (int tw = 0; tw < TPW; ++tw) {
          const int sigma = tau[tw] - delta;
          bf16x8 bf = {0, 0, 0, 0, 0, 0, 0, 0};
          if ((unsigned)sigma < (unsigned)T) bf = *(const bf16x8*)(SRC + bb[tw] * LDU + 8 * h + 32 * sigma + 16 * s2);
          acc[tw] = __builtin_amdgcn_mfma_f32_32x32x16_bf16(af, bf, acc[tw], 0, 0, 0);
        }
      }
    }
#pragma unroll
    for (int tw = 0; tw < TPW; ++tw) {
#pragma unroll
      for (int g4 = 0; g4 < 4; ++g4) {
        const int t = 32 * tau[tw] + 8 * g4 + 4 * h;
        const uint2 sv = *(const uint2*)(SRC + bb[tw] * LDU + t), xv = xpre[tw][g4];
        const float o0 = bflo(xv.x) * (acc[tw][4 * g4 + 0] + bflo(sv.x) * bias[order]);
        const float o1 = bfhi(xv.x) * (acc[tw][4 * g4 + 1] + bfhi(sv.x) * bias[order]);
        const float o2 = bflo(xv.y) * (acc[tw][4 * g4 + 2] + bflo(sv.y) * bias[order]);
        const float o3 = bfhi(xv.y) * (acc[tw][4 * g4 + 3] + bfhi(sv.y) * bias[order]);
        uint2 o; o.x = pack2(o0, o1); o.y = pack2(o2, o3);
        *(uint2*)(DST + bb[tw] * LDU + t) = o;
      }
    }
    __syncthreads();
  }
  for (int id = tid; id < NB * (N / 8); id += NT) {
    const int b = id / (N / 8), q = id % (N / 8);
    *(u32x4*)(HO + (size_t)ch * MTOK + (size_t)seq_row0(seq0 + b) + q * 8) = *(const u32x4*)(U + b * LDU + q * 8);
  }
}

DI void mix_dispatch(CParams& p, int l, int j, char* smem) {
  if (j < 64) { hgrn_item(p, l, 32 + (j >> 3), (j >> 1) & 3, j & 1, smem); return; }
  j -= 64;
  if (j < 256) { mla_item(p, l, 32 + (j >> 5), (j >> 3) & 3, j & 7, smem); return; }
  j -= 256;
  if (j < 256) { diff_item(p, l, 32 + (j >> 5), (j >> 3) & 3, j & 7, smem); return; }
  j -= 256;
  if (j < 256) { hyena_item<2048, 8>(p, l, 32, j, smem); return; }
  j -= 256;
  if (j < 256) { hgrn_item(p, l, j >> 3, (j >> 1) & 3, j & 1, smem); return; }
  j -= 256;
  if (j < 128) { mla_item(p, l, j >> 2, j & 3, 0, smem); return; }
  j -= 128;
  if (j < 128) { diff_item(p, l, j >> 2, j & 3, 0, smem); return; }
  j -= 128;
  hyena_item<256, 32>(p, l, 0, j, smem);
}
constexpr int MIX_ITEMS = 64 + 256 + 256 + 256 + 256 + 128 + 128 + 256;

DI void phase_mix(CParams& p, int l, char* smem) {
  int* slot = (int*)(smem + SLOT_OFF);
  unsigned* ctr = (unsigned*)(p.ws + WS_CTR) + l;
  for (;;) {
    __syncthreads();
    if (TID() == 0) *slot = (int)atomicAdd(ctr, 1u);
    __syncthreads();
    const int j = __builtin_amdgcn_readfirstlane(*slot);
    if (j >= MIX_ITEMS) break;
    mix_dispatch(p, l, j, smem);
  }
}

DI void phase_hcomb(CParams& p, int l) {
  const int lane = TID() & 63;
  const int gw = BID() * NW + (TID() >> 6), nw = gridDim.x * NW;
  const u16* PROJ = (const u16*)(p.ws + WS_ACT);
  const float* OF = (const float*)(p.ws + WS_OF);
  const float* OBW = (const float*)(p.ws + WS_OBW);
  u16* OB = (u16*)(p.ws + WS_HB);
  const float* g = p.in[I_ONORM] + l * 64 + (lane & 15) * 4;
  for (int r = gw; r < MTOK; r += nw) {
    float4 a = *(const float4*)(OF + (size_t)r * 256 + lane * 4);
    float4 b = *(const float4*)(OBW + (size_t)r * 256 + lane * 4);
    float o0 = a.x + b.x, o1 = a.y + b.y, o2 = a.z + b.z, o3 = a.w + b.w;
    float ss = o0 * o0 + o1 * o1 + o2 * o2 + o3 * o3;
    ss += __shfl_xor(ss, 1); ss += __shfl_xor(ss, 2); ss += __shfl_xor(ss, 4); ss += __shfl_xor(ss, 8);
    const float rstd = rsqrtf(ss * (1.f / 64.f) + EPS);
    uint2 raw = *(const uint2*)(PROJ + (size_t)r * INWP + 1024 + lane * 4);
    uint2 o;
    o.x = pack2(o0 * rstd * g[0] * silu_f(bflo(raw.x)), o1 * rstd * g[1] * silu_f(bfhi(raw.x)));
    o.y = pack2(o2 * rstd * g[2] * silu_f(bflo(raw.y)), o3 * rstd * g[3] * silu_f(bfhi(raw.y)));
    *(uint2*)(OB + (size_t)r * 1024 + lane * 4) = o;
  }
}

enum { PH_PRO = 0, PH_FILTNORM, PH_GU0, PH_DN0, PH_GIN, PH_PREP1, PH_GSMALL, PH_PREP2, PH_MIX, PH_HCOMB,
       PH_GOUT, PH_GU1, PH_DN1, PH_COUNT };

DI CParams* launder(CParams* q) { asm volatile("" : "+s"(q)); return q; }

DI void run_phase(CParams* pp, int ph, int l, char* smem) {
  CParams& p = *launder(pp);
  const u16* HB = (const u16*)(p.ws + WS_HB);
  u16* ACT = (u16*)(p.ws + WS_ACT);
  const float* MOD = (const float*)(p.ws + WS_MOD) + (size_t)l * 9 * 9216;
  using namespace pg8;
  GemmJob g0{}, g1{};
  bool is_gemm = false;
  switch (ph) {
    case PH_PRO: if (BID() == 0 && TID() < 64) ((unsigned*)(p.ws + WS_CTR))[TID()] = 0u; phase_wprep(p, smem); phase_mod(p, smem); phase_rope(p); phase_filt(p, smem); break;
    case PH_FILTNORM: phase_filtnorm(p); adaln_rows(p, 0, 0, BID() * NW + (TID() >> 6), gridDim.x * NW, MTOK, true); break;
    case PH_GU0:
    case PH_GU1: {
      const int f = ph == PH_GU1;
      g0 = GemmJob{Gemm{HB, (const u16*)(p.ws + WS_WGU) + (size_t)(l * 2 + f) * 5632 * 1024, MTOK, 5632, 1024},
                   Epi{EPI_GU, ACT, DFF, nullptr, nullptr, 0.f}};
      is_gemm = true;
    } break;
    case PH_DN0:
    case PH_DN1: {
      const int f = ph == PH_DN1;
      g0 = GemmJob{Gemm{ACT, (const u16*)(p.ws + WS_WDN) + (size_t)(l * 2 + f) * 1024 * 2816, MTOK, 1024, 2816},
                   Epi{EPI_RESID, nullptr, 0, p.out, MOD + (f ? 8192 : 2048), 0.5f}};
      is_gemm = true;
    } break;
    case PH_GIN: {
      g0 = GemmJob{Gemm{HB, (const u16*)(p.ws + WS_WIN) + (size_t)l * 3328 * 1024, MTOK, 3328, 1024},
                   Epi{EPI_BF16, ACT, INWP, nullptr, nullptr, 0.f}};
      is_gemm = true;
    } break;
    case PH_GSMALL: {
      g0 = GemmJob{Gemm{(const u16*)(p.ws + WS_CQ), (const u16*)(p.ws + WS_WUQ) + (size_t)l * 512 * 256, MTOK, 512, 256},
                   Epi{EPI_BF16, (u16*)(p.ws + WS_QRAW), 512, nullptr, nullptr, 0.f}};
      g1 = GemmJob{Gemm{(const u16*)(p.ws + WS_CKV), (const u16*)(p.ws + WS_WUKV) + (size_t)l * 512 * 256, NKV, 512, 256},
                   Epi{EPI_BF16, (u16*)(p.ws + WS_KVRAW), 512, nullptr, nullptr, 0.f}};
      is_gemm = true;
    } break;
    case PH_GOUT: {
      g0 = GemmJob{Gemm{HB, (const u16*)(p.ws + WS_WOUT) + (size_t)l * 1024 * 1024, MTOK, 1024, 1024},
                   Epi{EPI_RESID, nullptr, 0, p.out, MOD + 5120, 1.0f}};
      is_gemm = true;
    } break;
    case PH_PREP1: phase_prep1(p, l); phase_hyprep(p, l, smem); break;
    case PH_PREP2: phase_prep2(p, l); phase_vtm(p, smem); break;
    case PH_MIX: phase_mix(p, l, smem); break;
    case PH_HCOMB: phase_hcomb(p, l); phase_hypost(p, smem); break;
    default: break;
  }
  if (is_gemm) {
    int post_l = 0, post_which = 0, post_slot = -1;
    if (ph == PH_DN0) { post_l = l; post_which = 1; post_slot = l * 3 + 0; }
    else if (ph == PH_GOUT) { post_l = l; post_which = 2; post_slot = l * 3 + 1; }
    else if (ph == PH_DN1) { post_l = l + 1; post_which = 0; post_slot = l * 3 + 2; }
    int wjb = 0, wje = 0;
    if (l < 3) {
      if (ph == PH_DN0) { wjb = 0; wje = 2200; }
      else if (ph == PH_GOUT) { wjb = 2200; wje = 3100; }
      else if (ph == PH_DN1) { wjb = 3100; wje = WP_TILES; }
    }
    phase_gemm2(p, g0, g1, smem, post_l, post_which, post_slot, l + 1, wjb, wje);
  }
}

constexpr int SMEM_BYTES = XST_OFF + 64;

#if !MEGA
__global__ void __launch_bounds__(512, 2) k_phase(Params p_unused, int ph, int l) {
  extern __shared__ __attribute__((aligned(16))) char smem[];
  run_phase((CParams*)__builtin_amdgcn_kernarg_segment_ptr(), ph, l, smem);
}
#else
__global__ void __launch_bounds__(512, 2) k_mega(Params p_unused) {
  extern __shared__ __attribute__((aligned(16))) char smem[];
  cg::grid_group grid = cg::this_grid();
  CParams* pp = (CParams*)__builtin_amdgcn_kernarg_segment_ptr();
  volatile LAS unsigned* xst = (volatile LAS unsigned*)(LAS char*)(smem + XST_OFF);
  if (threadIdx.x == 0) { xst[0] = 0u; xst[1] = 0u; }
  __syncthreads();
  XcdBarrier xb = xcd_barrier_post((unsigned*)(pp->ws + WS_BAR), xst);
  for (int step = 0; step < 2 + 4 * (PH_COUNT - PH_GU0); ++step) {
    int ph, l;
    if (step < 2) { ph = step; l = 0; }
    else { const int j = step - 2; l = j / (PH_COUNT - PH_GU0); ph = PH_GU0 + j % (PH_COUNT - PH_GU0); }
    run_phase(pp, ph, l, smem);
    if (step == 0) grid.sync();
    else xcd_barrier(xb);
  }
}
#endif

extern "C" void kernel_launch(void* const* d_in, const int* in_sizes, int n_in, void* d_out, int out_size, void* d_ws,
                              size_t ws_size, hipStream_t stream) {
  Params p{};
  for (int i = 0; i < 33; ++i) p.in[i] = (const float*)d_in[i];
  p.out = (float*)d_out;
  p.ws = (char*)d_ws;
  if (ws_size < WS_END || n_in < 33) {
    fprintf(stderr, "workspace too small: %zu < %zu\n", ws_size, (size_t)WS_END);
    return;
  }
#if MEGA
  static int grid_blocks = 0;
  if (!grid_blocks) {
    int dev = 0, cus = 0, per_cu = 0;
    hipGetDevice(&dev);
    hipDeviceGetAttribute(&cus, hipDeviceAttributeMultiprocessorCount, dev);
    hipFuncSetAttribute((const void*)k_mega, hipFuncAttributeMaxDynamicSharedMemorySize, SMEM_BYTES);
    hipOccupancyMaxActiveBlocksPerMultiprocessor(&per_cu, k_mega, NT, SMEM_BYTES);
    if (per_cu > 1) per_cu = 1;
    grid_blocks = cus * per_cu;
  }
  (void)hipMemsetAsync((char*)d_ws + WS_CTR, 0, 256 + 16384 + 12 * 128 * 4, stream);
  void* args[] = {&p};
  hipError_t e = hipLaunchCooperativeKernel((void*)k_mega, dim3(grid_blocks), dim3(NT), args, SMEM_BYTES, stream);
  if (e != hipSuccess) fprintf(stderr, "cooperative launch failed: %s (grid %d)\n", hipGetErrorString(e), grid_blocks);
#else
  const int G = 256;
  hipFuncSetAttribute((const void*)k_phase, hipFuncAttributeMaxDynamicSharedMemorySize, SMEM_BYTES);
  k_phase<<<G, NT, SMEM_BYTES, stream>>>(p, PH_PRO, 0);
  k_phase<<<G, NT, SMEM_BYTES, stream>>>(p, PH_FILTNORM, 0);
  for (int l = 0; l < 4; ++l)
    for (int ph = PH_GU0; ph < PH_COUNT; ++ph) k_phase<<<G, NT, SMEM_BYTES, stream>>>(p, ph, l);
#endif
}
```

```cpp
#include <hip/hip_runtime.h>
#include <hip/hip_cooperative_groups.h>
#include <cstdio>
namespace cg = cooperative_groups;

#ifndef MEGA
#define MEGA 1
#endif

typedef unsigned short u16;
using bf16x8 = __attribute__((ext_vector_type(8))) short;
using bf16x4 = __attribute__((ext_vector_type(4))) short;
using f32x4 = __attribute__((ext_vector_type(4))) float;
using f32x16 = __attribute__((ext_vector_type(16))) float;
using u32x4 = __attribute__((ext_vector_type(4))) unsigned;
#define DI __device__ __forceinline__

constexpr int NT = 512, NW = 8;
constexpr int NCTX = 8192, NLAT = 16384, MTOK = 24576, NKV = 28672;
constexpr int DFF = 2816, INWP = 3328;
constexpr float EPS = 1e-6f;
constexpr float LOG2E = 1.4426950408889634f;
constexpr float MAXK = 1.0f - 1e-6f;

constexpr size_t O_MLA = 25165824, O_DK = 30408704, O_DV = 38797312, O_HG = 47185920;

constexpr size_t WS_WGU = 0;
constexpr size_t WS_WDN = WS_WGU + (size_t)8 * 5632 * 1024 * 2;
constexpr size_t WS_WIN = WS_WDN + (size_t)8 * 1024 * 2816 * 2;
constexpr size_t WS_WOUT = WS_WIN + (size_t)4 * 3328 * 1024 * 2;
constexpr size_t WS_WUQ = WS_WOUT + (size_t)4 * 1024 * 1024 * 2;
constexpr size_t WS_WUKV = WS_WUQ + (size_t)4 * 512 * 256 * 2;
constexpr size_t WS_MOD = WS_WUKV + (size_t)4 * 512 * 256 * 2;
constexpr size_t WS_ROPE = WS_MOD + (size_t)4 * 9 * 9216 * 4;
constexpr size_t WS_FILT = WS_ROPE + (size_t)2048 * 32 * 4;
constexpr size_t FILT_L = 2359296;
constexpr size_t WS_HB = WS_FILT + (size_t)4 * FILT_L * 4;
constexpr size_t WS_ACT = WS_HB + (size_t)MTOK * 1024 * 2;
constexpr size_t WS_CQ = WS_ACT + (size_t)MTOK * 3328 * 2;
constexpr size_t WS_CKV = WS_CQ + (size_t)MTOK * 256 * 2;
constexpr size_t WS_QRAW = WS_CKV + (size_t)NKV * 256 * 2;
constexpr size_t WS_KVRAW = WS_QRAW + (size_t)MTOK * 256 * 4;
constexpr size_t WS_OF = WS_QRAW;
constexpr size_t WS_OBW = WS_KVRAW;
constexpr size_t WS_QM = WS_KVRAW + (size_t)NKV * 512 * 2;
constexpr size_t WS_KM = WS_QM + (size_t)MTOK * 384 * 2;
constexpr size_t WS_VTM = WS_KM + (size_t)NKV * 384 * 2;
constexpr size_t WS_QD = WS_VTM + (size_t)NKV * 256 * 2;
constexpr size_t WS_KD = WS_QD + (size_t)MTOK * 256 * 2;
constexpr size_t WS_VTD = WS_KD + (size_t)NKV * 256 * 2;
constexpr size_t WS_HT = WS_VTD + (size_t)NKV * 256 * 2;
constexpr size_t WS_HO = WS_HT + (size_t)768 * MTOK * 2;
constexpr size_t WS_CTR = WS_HO + (size_t)256 * MTOK * 2;
constexpr size_t WS_BAR = WS_CTR + 256;
constexpr size_t WS_PCNT = WS_BAR + 16384;
constexpr size_t WS_END = WS_PCNT + 12 * 128 * 4;
constexpr int XST_OFF = 140288;
constexpr int SLOT_OFF = XST_OFF + 16;

struct Params {
  const float* in[33];
  float* out;
  char* ws;
};
typedef const __attribute__((address_space(4))) Params CParams;
enum { I_XP = 0, I_XS, I_C, I_CMLA, I_CDK, I_CDV, I_SHG, I_CCTX, I_WMOD, I_BMOD, I_NORMG, I_WGU, I_WDN, I_WIN, I_WOUT,
       I_LB, I_ONORM, I_QNORM, I_KVNORM, I_WUQ, I_WUKV, I_QKNORM, I_HYSHORT, I_HYW1, I_HYB1, I_HYW2, I_HYB2, I_HYW3,
       I_HYDEC, I_HYBIAS, I_DQKNORM, I_DLAM, I_DSUBLN };

#define LAS __attribute__((address_space(3)))
DI int TID() { int t = threadIdx.x; asm volatile("" : "+v"(t)); return t; }
DI int BID() { int t = blockIdx.x; asm volatile("" : "+s"(t)); return t; }
DI u16 f2bf(float x) { unsigned u = __float_as_uint(x); u += 0x7fffu + ((u >> 16) & 1u); return (u16)(u >> 16); }
DI float bf2f(u16 b) { return __uint_as_float(((unsigned)b) << 16); }
DI float bflo(unsigned u) { return __uint_as_float(u << 16); }
DI float bfhi(unsigned u) { return __uint_as_float(u & 0xffff0000u); }
typedef float f32x2v __attribute__((ext_vector_type(2)));
typedef __bf16 b16x2v __attribute__((ext_vector_type(2)));
DI unsigned pack2(float a, float b) { f32x2v v = {a, b}; return __builtin_bit_cast(unsigned, __builtin_convertvector(v, b16x2v)); }
DI float silu_f(float x) { return x * __builtin_amdgcn_rcpf(1.f + __builtin_amdgcn_exp2f(-x * LOG2E)); }
DI float sigm_f(float x) { return __builtin_amdgcn_rcpf(1.f + __builtin_amdgcn_exp2f(-x * LOG2E)); }
DI float wave_sum(float v) { for (int o = 32; o; o >>= 1) v += __shfl_xor(v, o); return v; }

DI int seq_nk(int s) { return s < 32 ? 256 : 2560; }
DI int seq_nq(int s) { return s < 32 ? 256 : 2048; }
DI size_t seq_kvb(int s) { return s < 32 ? (size_t)s * 256 : (size_t)8192 + (size_t)(s - 32) * 2560; }
DI int seq_row0(int s) { return s < 32 ? s * 256 : 8192 + (s - 32) * 2048; }

DI void transpose_tile(const float* __restrict__ src, int ldsrc, u16* __restrict__ dst, int lddst, int n0, int k0,
                       int nvalid, int kvalid, int mode, float* tile) {
  const int tid = TID();
  {
    const int n4 = (tid & 15) * 4, kq = tid >> 4;
    const int n = n0 + n4;
    int col = n;
    if (mode == 1) {
      const int tl = n >> 8, sl = n & 255, bj = sl >> 7, wc_ = (sl >> 5) & 3, nn = (sl >> 4) & 1, fq_ = (sl >> 2) & 3, j_ = sl & 3;
      const int o = tl * 128 + 8 * (wc_ * 4 + fq_) + bj * 4 + j_;
      col = nn ? 2816 + o : o;
    } else {
      const int rho = n & 31;
      col = (n & ~31) + 8 * ((rho & 15) >> 2) + 4 * (rho >> 4) + (rho & 3);
    }
    const bool valid = (mode == 1) ? true : (col < nvalid);
#pragma unroll
    for (int i = 0; i < 2; ++i) {
      const int k = i * 32 + kq;
      f32x4 v = {0.f, 0.f, 0.f, 0.f};
      if (valid && (k0 + k) < kvalid) v = __builtin_nontemporal_load((const f32x4*)(src + (size_t)(k0 + k) * ldsrc + col));
      float* tp = tile + k * 65 + n4;
      tp[0] = v[0]; tp[1] = v[1]; tp[2] = v[2]; tp[3] = v[3];
    }
  }
  __syncthreads();
  {
    const int kc = tid & 7, n = tid >> 3;
    const float* tp = tile + (kc * 8) * 65 + n;
    u32x4 o;
    o.x = pack2(tp[0], tp[65]); o.y = pack2(tp[130], tp[195]); o.z = pack2(tp[260], tp[325]); o.w = pack2(tp[390], tp[455]);
    *(u32x4*)(dst + (size_t)(n0 + n) * lddst + k0 + kc * 8) = o;
  }
  __syncthreads();
}

constexpr int WP_TILES = 5376;
DI void wprep_range(CParams& p, char* smem, int L, int jb, int je, int worker, int nworkers) {
  float* tile = (float*)smem;
  for (int j0 = jb + worker; j0 < je; j0 += nworkers) {
    int j = j0;
    if (j < 2816) {
      int f = j / 1408, rem = j % 1408, nt = rem / 16, kt = rem % 16, mat = L * 2 + f;
      transpose_tile(p.in[I_WGU] + (size_t)mat * 1024 * 5632, 5632, (u16*)(p.ws + WS_WGU) + (size_t)mat * 5632 * 1024, 1024,
                     nt * 64, kt * 64, 5632, 1024, 1, tile);
      continue;
    }
    j -= 2816;
    if (j < 1408) {
      int f = j / 704, rem = j % 704, nt = rem / 44, kt = rem % 44, mat = L * 2 + f;
      transpose_tile(p.in[I_WDN] + (size_t)mat * 2816 * 1024, 1024, (u16*)(p.ws + WS_WDN) + (size_t)mat * 1024 * 2816, 2816,
                     nt * 64, kt * 64, 1024, 2816, 0, tile);
      continue;
    }
    j -= 1408;
    if (j < 832) {
      int nt = j / 16, kt = j % 16;
      transpose_tile(p.in[I_WIN] + (size_t)L * 1024 * 3232, 3232, (u16*)(p.ws + WS_WIN) + (size_t)L * 3328 * 1024, 1024,
                     nt * 64, kt * 64, 3232, 1024, 0, tile);
      continue;
    }
    j -= 832;
    if (j < 256) {
      int nt = j / 16, kt = j % 16;
      transpose_tile(p.in[I_WOUT] + (size_t)L * 1024 * 1024, 1024, (u16*)(p.ws + WS_WOUT) + (size_t)L * 1024 * 1024, 1024,
                     nt * 64, kt * 64, 1024, 1024, 0, tile);
      continue;
    }
    j -= 256;
    if (j < 32) {
      int nt = j / 4, kt = j % 4;
      transpose_tile(p.in[I_WUQ] + (size_t)L * 256 * 384, 384, (u16*)(p.ws + WS_WUQ) + (size_t)L * 512 * 256, 256,
                     nt * 64, kt * 64, 384, 256, 0, tile);
      continue;
    }
    j -= 32;
    {
      int nt = j / 4, kt = j % 4;
      transpose_tile(p.in[I_WUKV] + (size_t)L * 128 * 512, 512, (u16*)(p.ws + WS_WUKV) + (size_t)L * 512 * 256, 256,
                     nt * 64, kt * 64, 512, 128, 0, tile);
    }
  }
}
DI void phase_wprep(CParams& p, char* smem) { wprep_range(p, smem, 0, 0, WP_TILES, BID(), gridDim.x); }

DI void phase_mod(CParams& p, char* smem) {
  float* s = (float*)smem;
  float* red = s + 9 * 1024;
  const int tid = TID(), lane = tid & 63, w = tid >> 6;
  float* MOD = (float*)(p.ws + WS_MOD);
  for (int id = BID(); id < 144; id += gridDim.x) {
    const int l = id / 36, n0 = (id % 36) * 256;
    __syncthreads();
    for (int i = tid; i < 9 * 1024; i += NT) {
      int c = i >> 10, k = i & 1023;
      float x = (c == 0) ? p.in[I_CCTX][k] : p.in[I_C][(c - 1) * 1024 + k];
      s[i] = silu_f(x);
    }
    __syncthreads();
    f32x4 acc[9];
#pragma unroll
    for (int c = 0; c < 9; ++c) acc[c] = f32x4{0.f, 0.f, 0.f, 0.f};
    const float* wp = p.in[I_WMOD] + ((size_t)l * 1024 + w * 128) * 9216 + n0 + lane * 4;
#pragma unroll 4
    for (int k = 0; k < 128; ++k) {
      const f32x4 wv = *(const f32x4*)(wp + (size_t)k * 9216);
#pragma unroll
      for (int c = 0; c < 9; ++c) acc[c] += wv * s[c * 1024 + w * 128 + k];
    }
#pragma unroll
    for (int c = 0; c < 9; ++c) *(f32x4*)&red[(w * 9 + c) * 256 + lane * 4] = acc[c];
    __syncthreads();
    for (int i = tid; i < 9 * 256; i += NT) {
      int c = i >> 8, ln = i & 255;
      float v = 0.f;
#pragma unroll
      for (int ww = 0; ww < NW; ++ww) v += red[(ww * 9 + c) * 256 + ln];
      MOD[((size_t)l * 9 + c) * 9216 + n0 + ln] = v + p.in[I_BMOD][l * 9216 + n0 + ln];
    }
  }
}

DI void phase_rope(CParams& p) {
  float* R = (float*)(p.ws + WS_ROPE);
  for (int i = BID() * NT + TID(); i < 2048 * 16; i += gridDim.x * NT) {
    int t = i >> 4, k = i & 15;
    float pos = (k < 8) ? (float)(t >> 6) : (float)(t & 63);
    float inv = powf(10000.f, -(float)(k & 7) / 8.f);
    float ang = pos * inv;
    R[t * 32 + k] = cosf(ang);
    R[t * 32 + 16 + k] = sinf(ang);
  }
}

DI float* filt_ptr(CParams& p, int l, int kind) { return (float*)(p.ws + WS_FILT) + (size_t)l * FILT_L + (kind ? 262144 : 0); }

DI void phase_filt(CParams& p, char* smem) {
  float* h1 = (float*)smem;
  float* h2 = h1 + 1024;
  const int tid = TID(), unit = tid & 63, tq = tid >> 6;
  for (int id = BID(); id < 576; id += gridDim.x) {
    const int l = id / 144, rem = id % 144;
    const int kind = rem < 16 ? 0 : 1, tb = rem < 16 ? rem : rem - 16;
    const int n = kind ? 2048 : 256, tau0 = tb * 16;
    const float* w1 = p.in[I_HYW1] + (size_t)l * 17 * 64;
    const float* w2 = p.in[I_HYW2] + (size_t)l * 64 * 64;
    const float* w3 = p.in[I_HYW3] + (size_t)l * 64 * 1024;
    __syncthreads();
    for (int j = 0; j < 2; ++j) {
      int ti = tq + 8 * j;
      float tn = (float)(tau0 + ti) / (float)n;
      float a = 6.283185307179586f * tn;
      float sacc = p.in[I_HYB1][l * 64 + unit] + tn * w1[unit];
      for (int k = 1; k <= 8; ++k) {
        float ak = a * (float)k;
        sacc += cosf(ak) * w1[k * 64 + unit] + sinf(ak) * w1[(8 + k) * 64 + unit];
      }
      h1[ti * 64 + unit] = sinf(sacc);
    }
    __syncthreads();
    for (int j = 0; j < 2; ++j) {
      int ti = tq + 8 * j;
      float sacc = p.in[I_HYB2][l * 64 + unit];
      for (int i = 0; i < 64; ++i) sacc += h1[ti * 64 + i] * w2[i * 64 + unit];
      h2[ti * 64 + unit] = sinf(sacc);
    }
    __syncthreads();
    float* FB = filt_ptr(p, l, kind);
    for (int cc = 0; cc < 2; ++cc) {
      const int col = tid + NT * cc;
      float wc[64];
#pragma unroll
      for (int i = 0; i < 64; ++i) wc[i] = w3[i * 1024 + col];
      const float dec = expf(p.in[I_HYDEC][l * 1024 + col]);
      const int dir = col >> 9, oc = col & 511;
      float* F = FB + (size_t)oc * 2 * n;
      for (int ti = 0; ti < 16; ++ti) {
        float v = 0.f;
#pragma unroll
        for (int i = 0; i < 64; ++i) v += h2[ti * 64 + i] * wc[i];
        const int tau = tau0 + ti;
        v *= expf(-dec * ((float)tau / (float)n));
        if (dir == 0) F[n + tau] = v;
        else if (tau >= 1) F[n - tau] = v;
        else F[0] = 0.f;
      }
    }
  }
}

DI void phase_filtnorm(CParams& p) {
  const int lane = TID() & 63;
  const int gw = BID() * NW + (TID() >> 6), nw = gridDim.x * NW;
  for (int id = gw; id < 4096; id += nw) {
    const int l = id >> 10, rem = id & 1023, kind = rem >> 9, oc = rem & 511;
    const int n2 = kind ? 4096 : 512;
    float* F = filt_ptr(p, l, kind) + (size_t)oc * n2;
    float s = 0.f;
    for (int i = lane; i < n2; i += 64) s += fabsf(F[i]);
    s = wave_sum(s);
    const float sc = 1.f / (s + EPS);
    for (int i = lane; i < n2; i += 64) F[i] *= sc;
  }
}

DI void phase_copyx(CParams& p) {
  float4* dst = (float4*)p.out;
  const float4* a = (const float4*)p.in[I_XP];
  const float4* b = (const float4*)p.in[I_XS];
  const size_t na = (size_t)NCTX * 256, nb = (size_t)NLAT * 256;
  for (size_t i = (size_t)BID() * NT + TID(); i < na + nb; i += (size_t)gridDim.x * NT)
    dst[i] = i < na ? a[i] : b[i - na];
}

#define XB_TMO      128
#define XB_XCNT(j)  (256  + 64 * (j))
#define XB_XSUB(j)  (1280 + 64 * (j))
#define XB_XGEN(j)  (2304 + 64 * (j))
#define XB_TOP      3328
#define XB_TOPGEN   3392
#define XCD_BAR_WORDS 3456
#define XB_SPIN_CAP (1u << 22)
DI unsigned xb_ld(unsigned* p) { return __hip_atomic_load(p, __ATOMIC_RELAXED, __HIP_MEMORY_SCOPE_AGENT); }
DI unsigned xb_add(unsigned* p, unsigned v) { return __hip_atomic_fetch_add(p, v, __ATOMIC_RELAXED, __HIP_MEMORY_SCOPE_AGENT); }
DI unsigned xb_xcc_id() { return (unsigned)__builtin_amdgcn_s_getreg((3 << 11) | 20) & 0xFu; }
#define XB_SPIN(cond, bar) do { unsigned _sp = 0; while (cond) { __builtin_amdgcn_s_sleep(1); \
    if ((++_sp & 255u) == 0u) { if (xb_ld(&(bar)[XB_TMO])) break; if (_sp > XB_SPIN_CAP) { atomicAdd(&(bar)[XB_TMO], 1u); break; } } } } while (0)
struct XcdBarrier { unsigned* bar; unsigned x; volatile LAS unsigned* st; };
DI XcdBarrier xcd_barrier_post(unsigned* bar, volatile LAS unsigned* st) {
  XcdBarrier b; b.bar = bar; b.x = xb_xcc_id(); b.st = st;
  if (threadIdx.x == 0) (void)xb_add(&bar[XB_XCNT(b.x)], 1u);
  return b;
}
DI void xcd_barrier_complete(unsigned* bar, unsigned x, unsigned& nloc, unsigned& nx) {
  const unsigned G = gridDim.x * gridDim.y * gridDim.z;
  unsigned sum, cnt, mine, sp = 0u;
  for (;;) {
    sum = 0u; cnt = 0u; mine = 0u;
#pragma unroll
    for (unsigned j = 0; j < 16; ++j) { const unsigned c = xb_ld(&bar[XB_XCNT(j)]); sum += c; cnt += (c > 0u) ? 1u : 0u; mine = (j == x) ? c : mine; }
    if (sum == G) break;
    __builtin_amdgcn_s_sleep(1);
    if ((++sp & 255u) == 0u) { if (xb_ld(&bar[XB_TMO])) break; if (sp > XB_SPIN_CAP) { atomicAdd(&bar[XB_TMO], 1u); break; } }
  }
  nloc = mine > 0u ? mine : 1u; nx = cnt > 0u ? cnt : 1u;
}
DI void xcd_barrier(const XcdBarrier& b) {
  asm volatile("s_waitcnt vmcnt(0)" ::: "memory");
  __syncthreads();
  if (threadIdx.x == 0) {
    unsigned* bar = b.bar;
    __builtin_amdgcn_s_waitcnt(0);
    unsigned nloc = b.st[0], nx = b.st[1];
    if (nloc == 0u) { xcd_barrier_complete(bar, b.x, nloc, nx); b.st[0] = nloc; b.st[1] = nx; }
    const unsigned old = xb_add(&bar[XB_XSUB(b.x)], 1u);
    const unsigned gen = old / nloc;
    if (old + 1u == (gen + 1u) * nloc) {
      __builtin_amdgcn_fence(__ATOMIC_RELEASE, "agent");
      asm volatile("s_waitcnt vmcnt(0)" ::: "memory");
      const unsigned og = xb_add(&bar[XB_TOP], 1u);
      const unsigned tg = og / nx;
      if (og + 1u == (tg + 1u) * nx) xb_add(&bar[XB_TOPGEN], 1u);
      else XB_SPIN(xb_ld(&bar[XB_TOPGEN]) == tg, bar);
      __builtin_amdgcn_fence(__ATOMIC_ACQUIRE, "agent");
      xb_add(&bar[XB_XGEN(b.x)], 1u);
      asm volatile("s_waitcnt vmcnt(0)" ::: "memory");
    } else {
      XB_SPIN(xb_ld(&bar[XB_XGEN(b.x)]) == gen, bar);
      __builtin_amdgcn_fence(__ATOMIC_ACQUIRE, "agent");
      asm volatile("s_waitcnt vmcnt(0)" ::: "memory");
    }
  }
  __syncthreads();
}

DI void adaln_rows(CParams& p, int l, int which, int gw, int nw, int MTOK_END, bool from_inputs = false);
DI void phase_adaln(CParams& p, int l, int which) {
  adaln_rows(p, l, which, BID() * NW + (TID() >> 6), gridDim.x * NW, MTOK);
}
DI void adaln_rows(CParams& p, int l, int which, int gw, int nw, int rend, bool from_inputs) {
  const int lane = TID() & 63;
  const float* MOD = (const float*)(p.ws + WS_MOD);
  u16* HB = (u16*)(p.ws + WS_HB);
  const float* g = p.in[I_NORMG] + (size_t)(l * 3 + which) * 1024;
  constexpr int RB = 4;
  for (int r0 = gw; r0 < rend; r0 += nw * RB) {
    float4 v[RB][4];
#pragma unroll
    for (int q = 0; q < RB; ++q) {
      const int r = r0 + q * nw;
      if (r < rend) {
        const float* x = (from_inputs ? (r < NCTX ? p.in[I_XP] + (size_t)r * 1024 : p.in[I_XS] + (size_t)(r - NCTX) * 1024) : p.out + (size_t)r * 1024);
#pragma unroll
        for (int i = 0; i < 4; ++i) {
          v[q][i] = *(const float4*)(x + i * 256 + lane * 4);
          if (from_inputs) *(float4*)(p.out + (size_t)r * 1024 + i * 256 + lane * 4) = v[q][i];
        }
      } else {
#pragma unroll
        for (int i = 0; i < 4; ++i) v[q][i] = float4{0.f, 0.f, 0.f, 0.f};
      }
    }
    float ss[RB];
#pragma unroll
    for (int q = 0; q < RB; ++q) {
      ss[q] = 0.f;
#pragma unroll
      for (int i = 0; i < 4; ++i) ss[q] += v[q][i].x * v[q][i].x + v[q][i].y * v[q][i].y + v[q][i].z * v[q][i].z + v[q][i].w * v[q][i].w;
    }
#pragma unroll
    for (int o = 32; o; o >>= 1)
#pragma unroll
      for (int q = 0; q < RB; ++q) ss[q] += __shfl_xor(ss[q], o);
#pragma unroll
    for (int q = 0; q < RB; ++q) {
      const int r = r0 + q * nw;
      if (r >= rend) continue;
      const int cond = r < NCTX ? 0 : 1 + ((r - NCTX) >> 11);
      const float* sh = MOD + ((size_t)l * 9 + cond) * 9216 + which * 3072;
      const float* sc = sh + 1024;
      const float rstd = rsqrtf(ss[q] * (1.f / 1024.f) + EPS);
#pragma unroll
      for (int i = 0; i < 4; ++i) {
        const int c = i * 256 + lane * 4;
        float4 gg = *(const float4*)(g + c), s4 = *(const float4*)(sc + c), h4 = *(const float4*)(sh + c);
        float y0 = v[q][i].x * rstd * gg.x * (1.f + s4.x) + h4.x;
        float y1 = v[q][i].y * rstd * gg.y * (1.f + s4.y) + h4.y;
        float y2 = v[q][i].z * rstd * gg.z * (1.f + s4.z) + h4.z;
        float y3 = v[q][i].w * rstd * gg.w * (1.f + s4.w) + h4.w;
        uint2 o; o.x = pack2(y0, y1); o.y = pack2(y2, y3);
        *(uint2*)(HB + (size_t)r * 1024 + c) = o;
      }
    }
  }
}

DI unsigned cvt_pk_bf16(float lo, float hi) { return pack2(lo, hi); }
namespace pg8 {
constexpr int BM = 256, BK = 64, HALF = 128, HTB = HALF * BK * 2, STAGE_BYTES = 8 * HTB, NXCD = 8, WGM = 8;
DI int lds_byte(int r, int c) { const int st = (r >> 4) * 2 + (c >> 5), rr = r & 15, cc = c & 31, ob = rr * 64 + cc * 2; return st * 1024 + (ob ^ (((ob >> 9) & 1) << 5)); }
DI void stage_rc(int b, int& R, int& C) { const int st = b / 1024, sb = b % 1024, swz = sb ^ (((sb >> 9) & 1) << 5); R = (st >> 1) * 16 + swz / 64; C = (st & 1) * 32 + (swz % 64) / 2; }
struct Unit { int pm, pn; };
struct Gemm { const u16* A; const u16* Bt; int M, N, K; };
struct StaticOrder {
  int nM, nN, nwg, G, c, panel;
  DI void init(int M, int N, int G_, int c_, int panel_ = 0) { nM = M / BM; nN = N / BM; nwg = nM * nN; G = G_; c = c_; panel = panel_; }
  DI int panel_of() const { const int xcd = c & 7, idx = c >> 3; return (idx >> 1) * 8 + xcd; }
  DI bool next(int i, Unit& u) const {
    if (panel) {
      const int pnl = panel_of();
      if (i >= 2 || pnl >= nM) return false;
      u.pm = pnl; u.pn = 2 * ((c >> 3) & 1) + i; return true;
    }
    const long L = (long)i * G + c; if (L >= nwg) return false;
    int wgid = (int)L; { const int q = nwg / NXCD, r = nwg % NXCD, xcd = wgid % NXCD, off = wgid / NXCD; wgid = (xcd < r ? xcd * (q + 1) : r * (q + 1) + (xcd - r) * q) + off; }
    const int nig = WGM * nN, gid = wgid / nig, fm = gid * WGM, gsz = (nM - fm) < WGM ? (nM - fm) : WGM;
    u.pm = fm + ((wgid % nig) % gsz); u.pn = (wgid % nig) / gsz; return true;
  }
};
enum { EPI_GU = 0, EPI_RESID = 1, EPI_BF16 = 2 };
struct Epi {
  int mode; u16* Cb; int ldc; float* X; const float* gvec; float coef;
  DI void operator()(const f32x4 (&acc)[2][2][4][2], const Unit& u, int wr, int wc, int fr, int fq) const {
    const int row0 = u.pm * BM + wr * 64 + fr, col0 = u.pn * BM + wc * 32 + 8 * fq;
    if (mode == EPI_GU) {
#pragma unroll
      for (int ai = 0; ai < 2; ++ai)
#pragma unroll
        for (int m = 0; m < 4; ++m) {
          u16* rowp = Cb + (size_t)(row0 + ai * HALF + m * 16) * ldc + u.pn * (BM / 2) + wc * 32 + 8 * fq;
          const f32x4 a0 = acc[ai][0][m][0], g0 = acc[ai][0][m][1], a1 = acc[ai][1][m][0], g1 = acc[ai][1][m][1];
          u32x4 o;
          o.x = cvt_pk_bf16(silu_f(a0[0]) * g0[0], silu_f(a0[1]) * g0[1]);
          o.y = cvt_pk_bf16(silu_f(a0[2]) * g0[2], silu_f(a0[3]) * g0[3]);
          o.z = cvt_pk_bf16(silu_f(a1[0]) * g1[0], silu_f(a1[1]) * g1[1]);
          o.w = cvt_pk_bf16(silu_f(a1[2]) * g1[2], silu_f(a1[3]) * g1[3]);
          *(u32x4*)rowp = o;
        }
    } else if (mode == EPI_RESID) {
      const int r0 = u.pm * BM;
      const int cond = r0 < NCTX ? 0 : 1 + ((r0 - NCTX) >> 11);
      const float* gv = gvec + (size_t)cond * 9216 + col0;
      f32x4 g4[2][2];
#pragma unroll
      for (int bj = 0; bj < 2; ++bj)
#pragma unroll
        for (int n = 0; n < 2; ++n) g4[bj][n] = *(const f32x4*)(gv + bj * HALF + n * 4) * coef;
#pragma unroll
      for (int ai = 0; ai < 2; ++ai)
#pragma unroll
        for (int m = 0; m < 4; ++m) {
          float* rowp = X + (size_t)(row0 + ai * HALF + m * 16) * 1024 + col0;
#pragma unroll
          for (int bj = 0; bj < 2; ++bj) {
            f32x4* xp = (f32x4*)(rowp + bj * HALF);
            const f32x4 x0 = xp[0], x1 = xp[1];
            xp[0] = x0 + g4[bj][0] * acc[ai][bj][m][0];
            xp[1] = x1 + g4[bj][1] * acc[ai][bj][m][1];
          }
        }
    } else {
#pragma unroll
      for (int ai = 0; ai < 2; ++ai)
#pragma unroll
        for (int m = 0; m < 4; ++m) {
          u16* rowp = Cb + (size_t)(row0 + ai * HALF + m * 16) * ldc + col0;
#pragma unroll
          for (int bj = 0; bj < 2; ++bj) {
            const f32x4 v0 = acc[ai][bj][m][0], v1 = acc[ai][bj][m][1];
            u32x4 o; o.x = cvt_pk_bf16(v0[0], v0[1]); o.y = cvt_pk_bf16(v0[2], v0[3]); o.z = cvt_pk_bf16(v1[0], v1[1]); o.w = cvt_pk_bf16(v1[2], v1[3]);
            *(u32x4*)(rowp + bj * HALF) = o;
          }
        }
    }
  }
};

DI void gemm_phase(LAS unsigned char* lds, const Gemm g, const StaticOrder& S, const Epi& E) {
  const int tid = TID(), wid = __builtin_amdgcn_readfirstlane(tid >> 6), lane = tid & 63, wr = wid >> 2, wc = wid & 3, fr = lane & 15, fq = lane >> 4;
  const int K = g.K, nt = K / BK;
  unsigned voffA[2];
#pragma unroll
  for (int i = 0; i < 2; ++i) { int R, C; stage_rc(tid * 16 + i * 8192, R, C); voffA[i] = (unsigned)(R * K + C) * 2u; }
  const size_t kstep = (size_t)(BK * 2);
  const size_t hstep = (size_t)HALF * K * 2;
  const size_t tstep = 2 * hstep;
  const unsigned ldsw = (unsigned)wid * 1024u;
  const int aoff = lds_byte(wr * 64 + fr, fq * 8), boff = lds_byte(wc * 32 + fr, fq * 8);
#define PG8_SA(b, h) (((b) * 2 + (h)) * HTB)
#define PG8_SB(b, h) ((4 + (b) * 2 + (h)) * HTB)
#define PG8_STAGE(bufoff, gbase) do { _Pragma("unroll") for (int _i = 0; _i < 2; ++_i) \
    __builtin_amdgcn_global_load_lds((const unsigned*)((const char*)(gbase) + voffA[_i]), (LAS unsigned*)(lds + (bufoff) + ldsw + _i * 8192), 16, 0, 0); } while (0)
#define PG8_LDA(dst, b, h) do { _Pragma("unroll") for (int m = 0; m < 4; ++m) _Pragma("unroll") for (int k = 0; k < 2; ++k) dst[m][k] = *(const LAS bf16x8*)(lds + PG8_SA(b, h) + aoff + m * 2048 + k * 1024); } while (0)
#define PG8_LDB(dst, b, h) do { _Pragma("unroll") for (int n = 0; n < 2; ++n) _Pragma("unroll") for (int k = 0; k < 2; ++k) dst[n][k] = *(const LAS bf16x8*)(lds + PG8_SB(b, h) + boff + n * 2048 + k * 1024); } while (0)
#define PG8_MMA(ai, bj, At, Bt) do { __builtin_amdgcn_s_setprio(1); _Pragma("unroll") for (int m = 0; m < 4; ++m) _Pragma("unroll") for (int n = 0; n < 2; ++n) _Pragma("unroll") for (int k = 0; k < 2; ++k) \
    acc[ai][bj][m][n] = __builtin_amdgcn_mfma_f32_16x16x32_bf16(Bt[n][k], At[m][k], acc[ai][bj][m][n], 0, 0, 0); __builtin_amdgcn_s_setprio(0); } while (0)
#define PG8_WAIT_V(n) asm volatile("s_waitcnt vmcnt(" #n ")" ::: "memory")
#define PG8_WAIT_L(n) asm volatile("s_waitcnt lgkmcnt(" #n ")" ::: "memory")
#define PG8_BAR __builtin_amdgcn_s_barrier()
#define PG8_SCHED __builtin_amdgcn_sched_barrier(0)
  Unit cur, nxt; int ui = 0;
  if (!S.next(0, cur)) return;
  f32x4 acc[2][2][4][2];
#pragma unroll
  for (int a = 0; a < 2; ++a)
#pragma unroll
    for (int b = 0; b < 2; ++b)
#pragma unroll
      for (int m = 0; m < 4; ++m)
#pragma unroll
        for (int n = 0; n < 2; ++n) acc[a][b][m][n] = (f32x4){0.f, 0.f, 0.f, 0.f};
  bf16x8 At[4][2], B0[2][2], B1[2][2];
  const char* cA = (const char*)g.A + (size_t)cur.pm * tstep; const char* cB = (const char*)g.Bt + (size_t)cur.pn * tstep;
  PG8_STAGE(PG8_SB(0, 0), cB); PG8_STAGE(PG8_SA(0, 0), cA); PG8_STAGE(PG8_SB(0, 1), cB + hstep); PG8_STAGE(PG8_SA(0, 1), cA + hstep);
  if (wr == 1) PG8_BAR;
  PG8_WAIT_V(4); PG8_BAR;
  PG8_STAGE(PG8_SB(1, 0), cB + kstep); PG8_STAGE(PG8_SA(1, 0), cA + kstep); PG8_STAGE(PG8_SB(1, 1), cB + hstep + kstep);
  PG8_WAIT_V(6); PG8_BAR;
  for (;;) {
    const bool has_next = S.next(ui + 1, nxt);
    const char* nA = has_next ? (const char*)g.A + (size_t)nxt.pm * tstep : cA; const char* nB = has_next ? (const char*)g.Bt + (size_t)nxt.pn * tstep : cB;
    for (int t = 0; t < nt; t += 2) {
      const bool last = (t == nt - 2);
      const char* a1 = cA + (size_t)(t + 1) * kstep;
      const char* a2 = last ? nA : cA + (size_t)(t + 2) * kstep; const char* b2 = last ? nB : cB + (size_t)(t + 2) * kstep;
      const char* a3 = a2 + kstep; const char* b3 = b2 + kstep;
      PG8_LDB(B0, 0, 0); PG8_SCHED; PG8_LDA(At, 0, 0); PG8_STAGE(PG8_SA(1, 1), a1 + hstep);
      PG8_WAIT_L(8); PG8_BAR; PG8_WAIT_L(0); PG8_MMA(0, 0, At, B0); PG8_BAR; PG8_SCHED;
      PG8_LDB(B1, 0, 1); PG8_STAGE(PG8_SB(0, 0), b2);
      PG8_BAR; PG8_WAIT_L(0); PG8_MMA(0, 1, At, B1); PG8_BAR;
      PG8_LDA(At, 0, 1); PG8_STAGE(PG8_SA(0, 0), a2);
      PG8_BAR; PG8_WAIT_L(0); PG8_MMA(1, 0, At, B0); PG8_BAR; PG8_SCHED;
      PG8_STAGE(PG8_SB(0, 1), b2 + hstep);
      PG8_WAIT_V(6); PG8_BAR; PG8_MMA(1, 1, At, B1); PG8_BAR;
      PG8_LDB(B0, 1, 0); PG8_SCHED; PG8_LDA(At, 1, 0); PG8_STAGE(PG8_SA(0, 1), a2 + hstep);
      PG8_WAIT_L(8); PG8_BAR; PG8_WAIT_L(0); PG8_MMA(0, 0, At, B0); PG8_BAR; PG8_SCHED;
      PG8_LDB(B1, 1, 1); PG8_STAGE(PG8_SB(1, 0), b3);
      PG8_BAR; PG8_WAIT_L(0); PG8_MMA(0, 1, At, B1); PG8_BAR;
      PG8_LDA(At, 1, 1); PG8_STAGE(PG8_SA(1, 0), a3);
      PG8_BAR; PG8_WAIT_L(0); PG8_MMA(1, 0, At, B0); PG8_BAR; PG8_SCHED;
      PG8_STAGE(PG8_SB(1, 1), b3 + hstep);
      PG8_WAIT_V(6); PG8_BAR; PG8_MMA(1, 1, At, B1); PG8_BAR;
    }
    E(acc, cur, wr, wc, fr, fq);
    if (!has_next) break;
#pragma unroll
    for (int a = 0; a < 2; ++a)
#pragma unroll
      for (int b = 0; b < 2; ++b)
#pragma unroll
        for (int m = 0; m < 4; ++m)
#pragma unroll
          for (int n = 0; n < 2; ++n) acc[a][b][m][n] = (f32x4){0.f, 0.f, 0.f, 0.f};
    cur = nxt; cA = nA; cB = nB; ++ui;
  }
  PG8_WAIT_V(0);
  if (wr == 0) PG8_BAR;
  PG8_BAR;
#undef PG8_SA
#undef PG8_SB
#undef PG8_STAGE
#undef PG8_LDA
#undef PG8_LDB
#undef PG8_MMA
#undef PG8_WAIT_V
#undef PG8_WAIT_L
#undef PG8_BAR
#undef PG8_SCHED
}
}

struct GemmJob { pg8::Gemm g; pg8::Epi e; };

DI void phase_gemm2(CParams& p, const GemmJob& g0, const GemmJob& g1, char* smem, int post_l, int post_which, int post_slot, int wl, int wjb, int wje) {
  LAS unsigned char* lds = (LAS unsigned char*)smem;
  pg8::StaticOrder S;
  const bool panel = post_slot >= 0;
  S.init(g0.g.M, g0.g.N, gridDim.x, BID(), panel ? 1 : 0);
  pg8::gemm_phase(lds, g0.g, S, g0.e);
  if (g1.g.M > 0) {
    __syncthreads();
    S.init(g1.g.M, g1.g.N, gridDim.x, BID());
    pg8::gemm_phase(lds, g1.g, S, g1.e);
  }
  __syncthreads();
  if (panel) {
    const int pnl = S.panel_of();
    if (pnl >= g0.g.M / 256) {
      if (wje > wjb) wprep_range(p, smem, wl, wjb, wje, (BID() >> 4) - 12 + 4 * (BID() & 7) + 32 * ((BID() >> 3) & 1), 64);
    }
    if (pnl < g0.g.M / 256) {
      unsigned* cnt = (unsigned*)(p.ws + WS_PCNT) + post_slot * 128 + pnl;
      asm volatile("s_waitcnt vmcnt(0)" ::: "memory");
      __syncthreads();
      if (threadIdx.x == 0) {
        __builtin_amdgcn_s_waitcnt(0);
        __builtin_amdgcn_fence(__ATOMIC_RELEASE, "agent");
        asm volatile("s_waitcnt vmcnt(0)" ::: "memory");
        xb_add(cnt, 1u);
        unsigned sp = 0;
        while (xb_ld(cnt) < 2u) { __builtin_amdgcn_s_sleep(1); if (++sp > XB_SPIN_CAP) break; }
        __builtin_amdgcn_fence(__ATOMIC_ACQUIRE, "agent");
        asm volatile("s_waitcnt vmcnt(0)" ::: "memory");
      }
      __syncthreads();
      if (post_l < 4) {
        const int half = (BID() >> 3) & 1;
        const int rb = pnl * 256 + half * 128;
        adaln_rows(p, post_l, post_which, rb + (TID() >> 6), NW, rb + 128);
      }
    }
  }
}

DI void tr_writeout(const u16* tile, int ldl, int C, int R, u16* dst, size_t dstride) {
  const int rq = R >> 3;
  for (int id = TID(); id < C * rq; id += NT) {
    const int q = id % rq, c = id / rq;
    const u16* tp = tile + (size_t)(8 * q) * ldl + c;
    u32x4 o;
    o.x = (unsigned)tp[0] | ((unsigned)tp[ldl] << 16);
    o.y = (unsigned)tp[2 * ldl] | ((unsigned)tp[3 * ldl] << 16);
    o.z = (unsigned)tp[4 * ldl] | ((unsigned)tp[5 * ldl] << 16);
    o.w = (unsigned)tp[6 * ldl] | ((unsigned)tp[7 * ldl] << 16);
    *(u32x4*)(dst + (size_t)c * dstride + 8 * q) = o;
  }
}

DI void phase_hyprep(CParams& p, int l, char* smem) {
  constexpr int LDL = 776, LDO = 770, LDV = 264;
  u16* tile = (u16*)smem;
  u16* outt = tile + 34 * LDL;
  u16* vtile = outt + 32 * LDO + 6;
  const u16* PROJ = (const u16*)(p.ws + WS_ACT);
  u16* HT = (u16*)(p.ws + WS_HT);
  u16* VTD = (u16*)(p.ws + WS_VTD);
  const float* wsh = p.in[I_HYSHORT] + (size_t)l * 3 * 768;
  const int tid = TID();
  vtile = (u16*)(smem + 106496);
  for (int tix = BID(); tix < MTOK / 32; tix += gridDim.x) {
    const int tok0 = tix * 32;
    const bool ctx = tok0 < NCTX;
    const int t0 = ctx ? (tok0 & 255) : ((tok0 - NCTX) & 2047), n = ctx ? 256 : 2048;
    const int seq = ctx ? (tok0 >> 8) : 32 + ((tok0 - NCTX) >> 11);
    const int nk = seq_nk(seq), key0 = ctx ? t0 : 512 + t0;
    __syncthreads();
    for (int id = tid; id < 34 * 96; id += NT) {
      const int r = id / 96, ch = id % 96;
      const int t = t0 + r - 1;
      u32x4 v = {0u, 0u, 0u, 0u};
      if (t >= 0 && t < n) v = *(const u32x4*)(PROJ + (size_t)(tok0 + r - 1) * INWP + 1696 + ch * 8);
      *(u32x4*)(tile + r * LDL + ch * 8) = v;
    }
    for (int id = tid; id < 32 * 32; id += NT) {
      const int r = id >> 5, ch = id & 31;
      *(u32x4*)(vtile + r * LDV + ch * 8) = *(const u32x4*)(PROJ + (size_t)(tok0 + r) * INWP + 2976 + ch * 8);
    }
    __syncthreads();
    tr_writeout(vtile, LDV, 256, 32, VTD + seq_kvb(seq) * 256 + key0, (size_t)nk);
    for (int id = tid; id < 768 * 4; id += NT) {
      const int q = id & 3, c = id >> 2;
      const u16* tp = tile + (8 * q) * LDL + c;
      const float w0 = wsh[c], w1 = wsh[768 + c], w2 = wsh[1536 + c];
      float x[10];
#pragma unroll
      for (int j = 0; j < 10; ++j) x[j] = bf2f(tp[j * LDL]);
      u32x4 o;
      o.x = pack2(w0 * x[0] + w1 * x[1] + w2 * x[2], w0 * x[1] + w1 * x[2] + w2 * x[3]);
      o.y = pack2(w0 * x[2] + w1 * x[3] + w2 * x[4], w0 * x[3] + w1 * x[4] + w2 * x[5]);
      o.z = pack2(w0 * x[4] + w1 * x[5] + w2 * x[6], w0 * x[5] + w1 * x[6] + w2 * x[7]);
      o.w = pack2(w0 * x[6] + w1 * x[7] + w2 * x[8], w0 * x[7] + w1 * x[8] + w2 * x[9]);
      *(u32x4*)(HT + (size_t)c * MTOK + tok0 + 8 * q) = o;
    }
  }
  for (int tix = BID(); tix < 128; tix += gridDim.x) {
    const int b = tix >> 4, tc0 = (tix & 15) * 32;
    __syncthreads();
    for (int id = tid; id < 32 * 64; id += NT) {
      const int r = id >> 6, c4 = id & 63;
      const float4 v = *(const float4*)(p.in[I_CDV] + (((size_t)b * 4 + l) * 512 + tc0 + r) * 256 + c4 * 4);
      uint2 o; o.x = pack2(v.x, v.y); o.y = pack2(v.z, v.w);
      *(uint2*)(vtile + r * LDV + c4 * 4) = o;
    }
    __syncthreads();
    tr_writeout(vtile, LDV, 256, 32, VTD + seq_kvb(32 + b) * 256 + tc0, (size_t)2560);
  }
}

DI void phase_vtm(CParams& p, char* smem) {
  constexpr int LDV = 264;
  u16* vtile = (u16*)smem;
  const u16* KVRAW = (const u16*)(p.ws + WS_KVRAW);
  u16* VTM = (u16*)(p.ws + WS_VTM);
  const int tid = TID();
  for (int tix = BID(); tix < NKV / 32; tix += gridDim.x) {
    const int kv0 = tix * 32;
    int seq, key0;
    if (kv0 < NCTX) { seq = kv0 >> 8; key0 = kv0 & 255; }
    else { const int rl = kv0 - NCTX; seq = 32 + rl / 2560; key0 = rl % 2560; }
    __syncthreads();
    for (int id = tid; id < 32 * 32; id += NT) {
      const int r = id >> 5, ch = id & 31;
      *(u32x4*)(vtile + r * LDV + ch * 8) = *(const u32x4*)(KVRAW + (size_t)(kv0 + r) * 512 + (ch >> 3) * 128 + 64 + (ch & 7) * 8);
    }
    __syncthreads();
    tr_writeout(vtile, LDV, 256, 32, VTM + seq_kvb(seq) * 256 + key0, (size_t)seq_nk(seq));
  }
}

DI void phase_hypost(CParams& p, char* smem) {
  constexpr int LDL = 264;
  u16* tile = (u16*)smem;
  const u16* HO = (const u16*)(p.ws + WS_HO);
  u16* OB = (u16*)(p.ws + WS_HB);
  const int tid = TID();
  for (int tix = BID(); tix < MTOK / 32; tix += gridDim.x) {
    const int tok0 = tix * 32;
    __syncthreads();
    for (int id = tid; id < 256 * 4; id += NT) {
      const int c = id >> 2, q = id & 3;
      const u32x4 v = *(const u32x4*)(HO + (size_t)c * MTOK + tok0 + q * 8);
      u16* tp = tile + (q * 8) * LDL + c;
      tp[0] = (u16)(v.x & 0xffff); tp[LDL] = (u16)(v.x >> 16);
      tp[2 * LDL] = (u16)(v.y & 0xffff); tp[3 * LDL] = (u16)(v.y >> 16);
      tp[4 * LDL] = (u16)(v.z & 0xffff); tp[5 * LDL] = (u16)(v.z >> 16);
      tp[6 * LDL] = (u16)(v.w & 0xffff); tp[7 * LDL] = (u16)(v.w >> 16);
    }
    __syncthreads();
    for (int id = tid; id < 32 * 32; id += NT) {
      const int tok = id >> 5, cq = id & 31;
      *(u32x4*)(OB + (size_t)(tok0 + tok) * 1024 + 512 + cq * 8) = *(const u32x4*)(tile + tok * LDL + cq * 8);
    }
  }
}

DI void phase_prep1(CParams& p, int l) {
  const int lane = TID() & 63;
  const int gw = BID() * NW + (TID() >> 6), nw = gridDim.x * NW;
  const u16* PROJ = (const u16*)(p.ws + WS_ACT);
  u16* CQ = (u16*)(p.ws + WS_CQ);
  u16* CKV = (u16*)(p.ws + WS_CKV);
  u16* QD = (u16*)(p.ws + WS_QD);
  u16* KD = (u16*)(p.ws + WS_KD);
  u16* VTD = (u16*)(p.ws + WS_VTD);
  const float* ROPE = (const float*)(p.ws + WS_ROPE);
  const float scaleq = 0.17677669529663687f * LOG2E;
  struct TokRaw { uint2 cq, dq, dk, dv; unsigned ckv, kr; float cs[4], sn[4]; };
  auto tok_load = [&](int r) {
    TokRaw w;
    const u16* pr = PROJ + (size_t)r * INWP;
    w.cq = *(const uint2*)(pr + 1280 + lane * 4);
    w.ckv = *(const unsigned*)(pr + 1536 + lane * 2);
    w.kr = pr[1664 + (lane & 31)];
    w.dq = *(const uint2*)(pr + 2464 + lane * 4);
    w.dk = *(const uint2*)(pr + 2720 + lane * 4);
    w.dv = *(const uint2*)(pr + 2976 + lane * 4);
    const int t = r < NCTX ? 0 : ((r - NCTX) & 2047);
#pragma unroll
    for (int i = 0; i < 4; ++i) {
      const int ti = ((lane & 4) ? 8 : 0) + (lane & 1) * 4 + i;
      w.cs[i] = ROPE[t * 32 + ti]; w.sn[i] = ROPE[t * 32 + 16 + ti];
    }
    return w;
  };
  auto tok_proc = [&](int r, const TokRaw& w) {
    const bool ctx = r < NCTX;
    int b, t;
    if (ctx) { b = r >> 8; t = r & 255; } else { int rl = r - NCTX; b = rl >> 11; t = rl & 2047; }
    const int seq = ctx ? b : 32 + b, nk = ctx ? 256 : 2560, key = ctx ? t : 512 + t;
    const size_t kvb = seq_kvb(seq);
    const size_t orow = ((size_t)b * 4 + l) * 256 + t;
    {
      float v0 = bflo(w.cq.x), v1 = bfhi(w.cq.x), v2 = bflo(w.cq.y), v3 = bfhi(w.cq.y);
      float ss = wave_sum(v0 * v0 + v1 * v1 + v2 * v2 + v3 * v3);
      float rstd = rsqrtf(ss * (1.f / 256.f) + EPS);
      const float* g = p.in[I_QNORM] + l * 256 + lane * 4;
      uint2 o; o.x = pack2(v0 * rstd * g[0], v1 * rstd * g[1]); o.y = pack2(v2 * rstd * g[2], v3 * rstd * g[3]);
      *(uint2*)(CQ + (size_t)r * 256 + lane * 4) = o;
    }
    {
      float v0 = bflo(w.ckv), v1 = bfhi(w.ckv);
      float ss = wave_sum(v0 * v0 + v1 * v1);
      float rstd = rsqrtf(ss * (1.f / 128.f) + EPS);
      const float* g = p.in[I_KVNORM] + l * 128 + lane * 2;
      float c0 = v0 * rstd * g[0], c1 = v1 * rstd * g[1];
      *(unsigned*)(CKV + (kvb + key) * 256 + lane * 2) = pack2(c0, c1);
      *(unsigned*)(CKV + (kvb + key) * 256 + 128 + lane * 2) = 0u;
      if (ctx) {
        float* om = p.out + O_MLA + orow * 160;
        *(float2*)(om + lane * 2) = float2{c0, c1};
        if (lane < 32) om[128 + lane] = bf2f((u16)w.kr);
      }
    }
#pragma unroll
    for (int which = 0; which < 2; ++which) {
      const uint2 raw = which ? w.dk : w.dq;
      float y[4] = {bflo(raw.x), bfhi(raw.x), bflo(raw.y), bfhi(raw.y)};
      float ss = y[0] * y[0] + y[1] * y[1] + y[2] * y[2] + y[3] * y[3];
      ss += __shfl_xor(ss, 1); ss += __shfl_xor(ss, 2); ss += __shfl_xor(ss, 4);
      const float rstd = rsqrtf(ss * (1.f / 32.f) + EPS);
      const int d0 = (lane & 7) * 4;
      const float* g = p.in[I_DQKNORM] + (l * 2 + which) * 32 + d0;
#pragma unroll
      for (int i = 0; i < 4; ++i) y[i] = y[i] * rstd * g[i];
      if (which == 1 && ctx) *(float4*)(p.out + O_DK + orow * 256 + lane * 4) = float4{y[0], y[1], y[2], y[3]};
      if (!ctx) {
#pragma unroll
        for (int i = 0; i < 4; ++i) {
          float pv = __shfl_xor(y[i], 2);
          y[i] = (lane & 2) ? (pv * w.sn[i] + y[i] * w.cs[i]) : (y[i] * w.cs[i] - pv * w.sn[i]);
        }
      }
      if (which == 0) {
        uint2 o; o.x = pack2(y[0] * scaleq, y[1] * scaleq); o.y = pack2(y[2] * scaleq, y[3] * scaleq);
        *(uint2*)(QD + (size_t)r * 256 + lane * 4) = o;
      } else {
        uint2 o; o.x = pack2(y[0], y[1]); o.y = pack2(y[2], y[3]);
        *(uint2*)(KD + kvb * 256 + ((size_t)(lane >> 3) * nk + key) * 32 + d0) = o;
      }
    }
    if (ctx) *(float4*)(p.out + O_DV + orow * 256 + lane * 4) = float4{bflo(w.dv.x), bfhi(w.dv.x), bflo(w.dv.y), bfhi(w.dv.y)};
  };
  for (int it = gw; it < MTOK; it += 2 * nw) {
    const int r0 = it, r1 = it + nw;
    const bool has1 = r1 < MTOK;
    const TokRaw w0 = tok_load(r0);
    const TokRaw w1 = tok_load(has1 ? r1 : r0);
    tok_proc(r0, w0);
    if (has1) tok_proc(r1, w1);
  }
  for (int j = gw; j < 4096; j += nw) {
    const int b = j >> 9, tc = j & 511;
    const size_t kvb = seq_kvb(32 + b);
    const int nk = 2560;
    const size_t crow = ((size_t)b * 4 + l) * 512 + tc;
    {
      float2 v = *(const float2*)(p.in[I_CMLA] + crow * 160 + lane * 2);
      *(unsigned*)(CKV + (kvb + tc) * 256 + lane * 2) = pack2(v.x, v.y);
      *(unsigned*)(CKV + (kvb + tc) * 256 + 128 + lane * 2) = 0u;
    }
    {
      float4 v = *(const float4*)(p.in[I_CDK] + crow * 256 + lane * 4);
      uint2 o; o.x = pack2(v.x, v.y); o.y = pack2(v.z, v.w);
      *(uint2*)(KD + kvb * 256 + ((size_t)(lane >> 3) * nk + tc) * 32 + (lane & 7) * 4) = o;
    }
  }
}

DI void phase_prep2(CParams& p, int l) {
  const int lane = TID() & 63, hh = lane >> 4, e = lane & 15;
  const int gw = BID() * NW + (TID() >> 6), nw = gridDim.x * NW;
  const u16* PROJ = (const u16*)(p.ws + WS_ACT);
  const u16* QRAW = (const u16*)(p.ws + WS_QRAW);
  const u16* KVRAW = (const u16*)(p.ws + WS_KVRAW);
  u16* QM = (u16*)(p.ws + WS_QM);
  u16* KM = (u16*)(p.ws + WS_KM);
  u16* VTM = (u16*)(p.ws + WS_VTM);
  const float* ROPE = (const float*)(p.ws + WS_ROPE);
  const float scalem = 0.10206207261596577f * LOG2E;
  for (int it = gw; it < MTOK + NKV; it += nw) {
    if (it < MTOK) {
      const int r = it;
      const bool ctx = r < NCTX;
      const int t = ctx ? (r & 255) : ((r - NCTX) & 2047);
      const u16* src = QRAW + (size_t)r * 512 + hh * 96;
      float y[6];
      float ss = 0.f;
#pragma unroll
      for (int i = 0; i < 6; ++i) { y[i] = bf2f(src[e + 16 * i]); ss += y[i] * y[i]; }
      ss += __shfl_xor(ss, 1); ss += __shfl_xor(ss, 2); ss += __shfl_xor(ss, 4); ss += __shfl_xor(ss, 8);
      const float rstd = rsqrtf(ss * (1.f / 96.f) + EPS);
      const float* g = p.in[I_QKNORM] + (l * 2 + 0) * 96;
#pragma unroll
      for (int i = 0; i < 6; ++i) y[i] = y[i] * rstd * g[e + 16 * i];
      if (!ctx) {
#pragma unroll
        for (int i = 4; i < 6; ++i) {
          float pv = __shfl_xor(y[i], 8);
          const int ti = (i == 5 ? 8 : 0) + (e & 7);
          const float cs = ROPE[t * 32 + ti], sn = ROPE[t * 32 + 16 + ti];
          y[i] = (e & 8) ? (pv * sn + y[i] * cs) : (y[i] * cs - pv * sn);
        }
      }
      u16* dst = QM + (size_t)r * 384 + hh * 96;
#pragma unroll
      for (int i = 0; i < 6; ++i) dst[e + 16 * i] = f2bf(y[i] * scalem);
    } else {
      const int kvrow = it - MTOK;
      int seq, key, t = 0;
      bool rope = false;
      const u16* kr_bf = nullptr;
      const float* kr_f = nullptr;
      if (kvrow < NCTX) {
        seq = kvrow >> 8; key = kvrow & 255;
        kr_bf = PROJ + (size_t)kvrow * INWP + 1664;
      } else {
        const int rl = kvrow - NCTX, b = rl / 2560;
        key = rl - b * 2560; seq = 32 + b;
        if (key < 512) kr_f = p.in[I_CMLA] + (((size_t)b * 4 + l) * 512 + key) * 160 + 128;
        else { t = key - 512; rope = true; kr_bf = PROJ + (size_t)(NCTX + b * 2048 + t) * INWP + 1664; }
      }
      const int nk = seq_nk(seq);
      const size_t kvb = seq_kvb(seq);
      const u16* src = KVRAW + (size_t)kvrow * 512 + hh * 128;
      float y[6];
      float ss = 0.f;
#pragma unroll
      for (int i = 0; i < 4; ++i) y[i] = bf2f(src[e + 16 * i]);
#pragma unroll
      for (int i = 4; i < 6; ++i) y[i] = kr_bf ? bf2f(kr_bf[e + 16 * (i - 4)]) : kr_f[e + 16 * (i - 4)];
#pragma unroll
      for (int i = 0; i < 6; ++i) ss += y[i] * y[i];
      ss += __shfl_xor(ss, 1); ss += __shfl_xor(ss, 2); ss += __shfl_xor(ss, 4); ss += __shfl_xor(ss, 8);
      const float rstd = rsqrtf(ss * (1.f / 96.f) + EPS);
      const float* g = p.in[I_QKNORM] + (l * 2 + 1) * 96;
#pragma unroll
      for (int i = 0; i < 6; ++i) y[i] = y[i] * rstd * g[e + 16 * i];
      if (rope) {
#pragma unroll
        for (int i = 4; i < 6; ++i) {
          float pv = __shfl_xor(y[i], 8);
          const int ti = (i == 5 ? 8 : 0) + (e & 7);
          const float cs = ROPE[t * 32 + ti], sn = ROPE[t * 32 + 16 + ti];
          y[i] = (e & 8) ? (pv * sn + y[i] * cs) : (y[i] * cs - pv * sn);
        }
      }
      u16* dst = KM + kvb * 384 + ((size_t)hh * nk + key) * 96;
#pragma unroll
      for (int i = 0; i < 6; ++i) dst[e + 16 * i] = f2bf(y[i]);
    }
  }
}

DI int crow(int i, int h) { return (i & 3) + 8 * (i >> 2) + 4 * h; }

template <int DQK, int NMAP>
DI void attn_wave(CParams& p, int l, const u16* __restrict__ Q, int qstride, int qmapstride,
                  const u16* __restrict__ K, size_t kmapstride, const u16* __restrict__ Vt, int nk, int orow0, int ocol0, char* smem) {
  constexpr int NS = DQK / 16, LDK = DQK + 8, LDV = 72;
  constexpr int KCH = NMAP * 64 * DQK / 8;
  constexpr int KSZ = NMAP * 64 * LDK, STG = KSZ + 64 * LDV;
  u16* lds = (u16*)smem;
  const int tid = TID(), lane = tid & 63, r = lane & 31, h = lane >> 5;
  bf16x8 bq[NMAP][NS];
#pragma unroll
  for (int m = 0; m < NMAP; ++m)
#pragma unroll
    for (int s = 0; s < NS; ++s) bq[m][s] = *(const bf16x8*)(Q + (size_t)r * qstride + m * qmapstride + 16 * s + 8 * h);
  f32x16 O[NMAP][2];
  float mrun[NMAP], lsum[NMAP];
#pragma unroll
  for (int m = 0; m < NMAP; ++m) {
    mrun[m] = 0.f; lsum[m] = 0.f;
#pragma unroll
    for (int mt = 0; mt < 2; ++mt)
#pragma unroll
      for (int i = 0; i < 16; ++i) O[m][mt][i] = 0.f;
  }
  u32x4 rk0, rk1, rv;
  const int kc0 = tid, kc1 = tid + NT;
  constexpr int CPK = DQK / 8;
  const int k0m = kc0 / (64 * CPK), k0key = (kc0 / CPK) % 64, k0c = kc0 % CPK;
  const int k1m = kc1 / (64 * CPK), k1key = (kc1 / CPK) % 64, k1c = kc1 % CPK;
  const u16* gk0 = K + k0m * kmapstride + (size_t)k0key * DQK + k0c * 8;
  const u16* gk1 = K + k1m * kmapstride + (size_t)k1key * DQK + k1c * 8;
  const int lk0 = (k0m * 64 + k0key) * LDK + k0c * 8, lk1 = (k1m * 64 + k1key) * LDK + k1c * 8;
  const int vdv = tid >> 3, vq = tid & 7;
  const u16* gv = Vt + (size_t)vdv * nk + vq * 8;
  const int lv = KSZ + vdv * LDV + vq * 8;
#define ATTN_GLOAD(K0)                                                      \
  {                                                                         \
    rk0 = *(const u32x4*)(gk0 + (size_t)(K0) * DQK);                        \
    if (KCH > NT && kc1 < KCH) rk1 = *(const u32x4*)(gk1 + (size_t)(K0) * DQK); \
    rv = *(const u32x4*)(gv + (K0));                                        \
  }
  ATTN_GLOAD(0)
  __syncthreads();
  const int ntile = nk >> 6;
  for (int t = 0; t < ntile; ++t) {
    u16* st = lds + (t & 1) * STG;
    *(u32x4*)(st + lk0) = rk0;
    if (KCH > NT && kc1 < KCH) *(u32x4*)(st + lk1) = rk1;
    *(u32x4*)(st + lv) = rv;
    __syncthreads();
    if (t + 1 < ntile) ATTN_GLOAD((t + 1) * 64)
    f32x16 accs[2][NMAP];
#pragma unroll
    for (int sub = 0; sub < 2; ++sub)
#pragma unroll
      for (int m = 0; m < NMAP; ++m) {
#pragma unroll
        for (int i = 0; i < 16; ++i) accs[sub][m][i] = -mrun[m];
        const u16* kp = st + (m * 64 + sub * 32 + r) * LDK + 8 * h;
#pragma unroll
        for (int s = 0; s < NS; ++s) {
          const bf16x8 ak = *(const bf16x8*)(kp + 16 * s);
          accs[sub][m] = __builtin_amdgcn_mfma_f32_32x32x16_bf16(ak, bq[m][s], accs[sub][m], 0, 0, 0);
        }
      }
#pragma unroll
    for (int sub = 0; sub < 2; ++sub) {
      bf16x8 av[2][2];
#pragma unroll
      for (int mt = 0; mt < 2; ++mt)
#pragma unroll
        for (int s2 = 0; s2 < 2; ++s2) {
          const u16* vp = st + KSZ + (mt * 32 + r) * LDV + sub * 32 + 16 * s2 + 4 * h;
          bf16x4 lo = *(const bf16x4*)vp, hi = *(const bf16x4*)(vp + 8);
          av[mt][s2] = __builtin_shufflevector(lo, hi, 0, 1, 2, 3, 4, 5, 6, 7);
        }
#pragma unroll
      for (int m = 0; m < NMAP; ++m) {
        f32x16& acc = accs[sub][m];
        float mx = fmaxf(acc[0], acc[1]);
#pragma unroll
        for (int i = 2; i < 16; i += 2) mx = fmaxf(mx, fmaxf(acc[i], acc[i + 1]));
        const bool first = (t == 0 && sub == 0);
        if (first || __builtin_amdgcn_ballot_w64(mx > 8.f) != 0ull) {
          const float mp = fmaxf(mx, __shfl_xor(mx, 32));
          const float d = first ? mp : fmaxf(mp, 0.f);
          const float alpha = first ? 1.f : __builtin_amdgcn_exp2f(-d);
          mrun[m] += d;
          lsum[m] *= alpha;
#pragma unroll
          for (int mt = 0; mt < 2; ++mt)
#pragma unroll
            for (int i = 0; i < 16; ++i) O[m][mt][i] *= alpha;
#pragma unroll
          for (int i = 0; i < 16; ++i) acc[i] -= d;
          if (sub == 0) {
#pragma unroll
            for (int i = 0; i < 16; ++i) accs[1][m][i] -= d;
          }
        }
        float ps = 0.f;
#pragma unroll
        for (int i = 0; i < 16; ++i) { acc[i] = __builtin_amdgcn_exp2f(acc[i]); ps += acc[i]; }
        lsum[m] += ps;
        bf16x8 pf[2];
#pragma unroll
        for (int s2 = 0; s2 < 2; ++s2) {
          u32x4 pk;
          pk.x = pack2(acc[8 * s2 + 0], acc[8 * s2 + 1]); pk.y = pack2(acc[8 * s2 + 2], acc[8 * s2 + 3]);
          pk.z = pack2(acc[8 * s2 + 4], acc[8 * s2 + 5]); pk.w = pack2(acc[8 * s2 + 6], acc[8 * s2 + 7]);
          pf[s2] = __builtin_bit_cast(bf16x8, pk);
        }
#pragma unroll
        for (int mt = 0; mt < 2; ++mt)
#pragma unroll
          for (int s2 = 0; s2 < 2; ++s2)
            O[m][mt] = __builtin_amdgcn_mfma_f32_32x32x16_bf16(av[mt][s2], pf[s2], O[m][mt], 0, 0, 0);
      }
    }
  }
#undef ATTN_GLOAD
  u16* OB = (u16*)(p.ws + WS_HB);
  u16* op = OB + (size_t)(orow0 + r) * 1024 + ocol0;
  if (NMAP == 1) {
    const float inv = 1.f / (lsum[0] + __shfl_xor(lsum[0], 32));
#pragma unroll
    for (int mt = 0; mt < 2; ++mt)
#pragma unroll
      for (int g = 0; g < 4; ++g) {
        uint2 o;
        o.x = pack2(O[0][mt][4 * g] * inv, O[0][mt][4 * g + 1] * inv);
        o.y = pack2(O[0][mt][4 * g + 2] * inv, O[0][mt][4 * g + 3] * inv);
        *(uint2*)(op + mt * 32 + 8 * g + 4 * h) = o;
      }
  } else {
    const float* dl = p.in[I_DLAM] + l * 128;
    float a = 0.f, b = 0.f;
    if (lane < 32) { a = dl[lane] * dl[32 + lane]; b = dl[64 + lane] * dl[96 + lane]; }
    a = wave_sum(a); b = wave_sum(b);
    const float lam_init = 0.8f - 0.6f * expf(-0.3f * (float)l);
    const float lam = expf(a) - expf(b) + lam_init;
    const float inv0 = 1.f / (lsum[0] + __shfl_xor(lsum[0], 32));
    const float inv1 = lam / (lsum[NMAP - 1] + __shfl_xor(lsum[NMAP - 1], 32));
    float ss = 0.f;
#pragma unroll
    for (int mt = 0; mt < 2; ++mt)
#pragma unroll
      for (int i = 0; i < 16; ++i) {
        float o = O[0][mt][i] * inv0 - O[NMAP - 1][mt][i] * inv1;
        O[0][mt][i] = o;
        ss += o * o;
      }
    ss += __shfl_xor(ss, 32);
    const float rstd = rsqrtf(ss * (1.f / 64.f) + EPS) * (1.f - lam_init);
    const float* sg = p.in[I_DSUBLN] + l * 64;
#pragma unroll
    for (int mt = 0; mt < 2; ++mt)
#pragma unroll
      for (int g = 0; g < 4; ++g) {
        const int dv = mt * 32 + 8 * g + 4 * h;
        uint2 o;
        o.x = pack2(O[0][mt][4 * g] * rstd * sg[dv], O[0][mt][4 * g + 1] * rstd * sg[dv + 1]);
        o.y = pack2(O[0][mt][4 * g + 2] * rstd * sg[dv + 2], O[0][mt][4 * g + 3] * rstd * sg[dv + 3]);
        *(uint2*)(op + dv) = o;
      }
  }
}

DI void mla_item(CParams& p, int l, int seq, int head, int qb, char* smem) {
  const int w = TID() >> 6;
  const int nk = seq_nk(seq), row0 = seq_row0(seq), q0 = qb * 256 + w * 32;
  const size_t kvb = seq_kvb(seq);
  const u16* Q = (const u16*)(p.ws + WS_QM) + (size_t)(row0 + q0) * 384 + head * 96;
  const u16* K = (const u16*)(p.ws + WS_KM) + kvb * 384 + (size_t)head * nk * 96;
  const u16* Vt = (const u16*)(p.ws + WS_VTM) + kvb * 256 + (size_t)head * 64 * nk;
  attn_wave<96, 1>(p, l, Q, 384, 0, K, 0, Vt, nk, row0 + q0, 256 + head * 64, smem);
}
DI void diff_item(CParams& p, int l, int seq, int head, int qb, char* smem) {
  const int w = TID() >> 6;
  const int nk = seq_nk(seq), row0 = seq_row0(seq), q0 = qb * 256 + w * 32;
  const size_t kvb = seq_kvb(seq);
  const u16* Q = (const u16*)(p.ws + WS_QD) + (size_t)(row0 + q0) * 256 + head * 64;
  const u16* K = (const u16*)(p.ws + WS_KD) + kvb * 256 + (size_t)(head * 2) * nk * 32;
  const u16* Vt = (const u16*)(p.ws + WS_VTD) + kvb * 256 + (size_t)head * 64 * nk;
  attn_wave<32, 2>(p, l, Q, 256, 32, K, (size_t)nk * 32, Vt, nk, row0 + q0, 768 + head * 64, smem);
}

DI float dpp_add(float x, float acc_src, int) { return x + acc_src; }
#define DPP_F(x, ctrl) __builtin_bit_cast(float, __builtin_amdgcn_update_dpp(0, __builtin_bit_cast(int, (x)), (ctrl), 0xF, 0xF, false))
DI float red16(float o) {
  o += DPP_F(o, 0xB1);
  o += DPP_F(o, 0x4E);
  o += DPP_F(o, 0x141);
  o += DPP_F(o, 0x140);
  return o;
}
DI float red8(float o) {
  o += DPP_F(o, 0xB1);
  o += DPP_F(o, 0x4E);
  o += DPP_F(o, 0x141);
  return o;
}
DI void hgrn_item(CParams& p, int l, int seq, int head, int dir, char* smem) {
  constexpr int CH = 64;
  float* qs = (float*)smem;
  float* ks = qs + CH * 64;
  float* vs = ks + CH * 64;
  const int tid = TID(), v = tid >> 3, kq = tid & 7, e = tid & 63;
  const int L = seq_nq(seq), row0 = seq_row0(seq);
  const bool ctx = seq < 32;
  const int b = ctx ? seq : seq - 32;
  const u16* PROJ = (const u16*)(p.ws + WS_ACT);
  float* OUTB = (float*)(p.ws + (dir ? WS_OBW : WS_OF));
  float oml;
  {
    const float* lg = p.in[I_LB] + (size_t)dir * 1024 + head * 64 + e;
    float l0 = lg[0], l1 = lg[256], l2 = lg[512], l3 = lg[768];
    float mx = fmaxf(fmaxf(l0, l1), fmaxf(l2, l3));
    float e0 = expf(l0 - mx), e1 = expf(l1 - mx), e2 = expf(l2 - mx), e3 = expf(l3 - mx);
    float tot = e0 + e1 + e2 + e3;
    float lb = ((l >= 1 ? e1 : 0.f) + (l >= 2 ? e2 : 0.f) + (l >= 3 ? e3 : 0.f)) / tot;
    oml = 1.f - lb;
  }
  f32x2v S[4];
  const size_t sbase = ((((size_t)b * 4 + l) * 2 + dir) * 4 + head) * 4096;
  {
    const float* sp = p.in[I_SHG] + sbase + (size_t)(kq * 8) * 64 + v;
#pragma unroll
    for (int i = 0; i < 4; ++i) { S[i].x = ctx ? 0.f : sp[(2 * i) * 64]; S[i].y = ctx ? 0.f : sp[(2 * i + 1) * 64]; }
  }
  const int foff = dir ? 768 : 512;
  u16 rq[8], ri[8], rf[8];
#define HGRN_FETCH(N0)                                                              \
  _Pragma("unroll") for (int i4 = 0; i4 < 8; ++i4) {                                \
    const int idx = tid + i4 * NT, tt = idx >> 6, n = (N0) + tt, t = dir ? L - 1 - n : n; \
    const u16* pr = PROJ + (size_t)(row0 + t) * INWP + head * 64 + e;               \
    rq[i4] = pr[0]; ri[i4] = pr[256]; rf[i4] = pr[foff];                            \
  }
  HGRN_FETCH(0)
  for (int n0 = 0; n0 < L; n0 += CH) {
    __syncthreads();
#pragma unroll
    for (int i4 = 0; i4 < 8; ++i4) {
      const int idx = tid + i4 * NT;
      qs[idx] = silu_f(bf2f(rq[i4])) * 0.125f;
      vs[idx] = bf2f(ri[i4]);
      ks[idx] = fminf(oml * sigm_f(-bf2f(rf[i4])), MAXK);
    }
    __syncthreads();
    if (n0 + CH < L) { HGRN_FETCH(n0 + CH) }
    float vt = vs[v];
    f32x4 ka = *(const f32x4*)&ks[kq * 8], kb = *(const f32x4*)&ks[kq * 8 + 4];
    f32x4 qa = *(const f32x4*)&qs[kq * 8], qb = *(const f32x4*)&qs[kq * 8 + 4];
    for (int t8 = 0; t8 < CH; t8 += 8) {
      float keep = 0.f;
#pragma unroll
      for (int uu = 0; uu < 8; ++uu) {
        const int tt = t8 + uu;
        const int t1 = tt + 1 < CH ? tt + 1 : CH - 1;
        const float vtn = vs[t1 * 64 + v];
        const f32x4 kan = *(const f32x4*)&ks[t1 * 64 + kq * 8], kbn = *(const f32x4*)&ks[t1 * 64 + kq * 8 + 4];
        const f32x4 qan = *(const f32x4*)&qs[t1 * 64 + kq * 8], qbn = *(const f32x4*)&qs[t1 * 64 + kq * 8 + 4];
        const f32x2v vv2 = {vt, vt};
        const f32x2v k2[4] = {{ka[0], ka[1]}, {ka[2], ka[3]}, {kb[0], kb[1]}, {kb[2], kb[3]}};
        const f32x2v q2[4] = {{qa[0], qa[1]}, {qa[2], qa[3]}, {qb[0], qb[1]}, {qb[2], qb[3]}};
        f32x2v o2 = {0.f, 0.f};
#pragma unroll
        for (int i = 0; i < 4; ++i) {
          S[i] = __builtin_elementwise_fma(k2[i], vv2 - S[i], S[i]);
          o2 = __builtin_elementwise_fma(S[i], q2[i], o2);
        }
        const float o = red8(o2.x + o2.y);
        keep = (kq == uu) ? o : keep;
        vt = vtn; ka = kan; kb = kbn; qa = qan; qb = qbn;
      }
      {
        const int n = n0 + t8 + kq, t = dir ? L - 1 - n : n;
        OUTB[(size_t)(row0 + t) * 256 + head * 64 + v] = keep;
      }
    }
  }
  if (ctx) {
    float* sp = p.out + O_HG + sbase + (size_t)(kq * 8) * 64 + v;
#pragma unroll
    for (int i = 0; i < 4; ++i) { sp[(2 * i) * 64] = S[i].x; sp[(2 * i + 1) * 64] = S[i].y; }
  }
}

#undef HGRN_FETCH
template <int N, int NB>
DI void hyena_item(CParams& p, int l, int seq0, int ch, char* smem) {
  constexpr int T = N / 32, LDU = N + 8, NBG = NB / 8, NTILES = NBG * (T / 4), TPW = NTILES / NW, LDR = 2 * N + 8;
  u16* U = (u16*)smem;
  u16* Z = U + NB * LDU;
  u16* RC = Z + NB * LDU;
  u16* R = RC + 8 * LDR;
  const int tid = TID(), lane = tid & 63, w = tid >> 6, r = lane & 31, h = lane >> 5;
  const u16* HT = (const u16*)(p.ws + WS_HT);
  u16* HO = (u16*)(p.ws + WS_HO);
  const float* FB = filt_ptr(p, l, N == 2048 ? 1 : 0);
  const float bias[2] = {p.in[I_HYBIAS][(l * 2 + 0) * 256 + ch], p.in[I_HYBIAS][(l * 2 + 1) * 256 + ch]};
  __syncthreads();
  for (int id = tid; id < NB * (N / 8); id += NT) {
    const int b = id / (N / 8), q = id % (N / 8);
    *(u32x4*)(U + b * LDU + q * 8) = *(const u32x4*)(HT + (size_t)ch * MTOK + (size_t)seq_row0(seq0 + b) + q * 8);
  }
#pragma unroll
  for (int order = 0; order < 2; ++order) {
    const float* G = FB + (size_t)(order * 256 + ch) * 2 * N;
    for (int x = tid; x < 2 * N + 16; x += NT) R[x] = x < 2 * N ? f2bf(G[2 * N - 1 - x]) : (u16)0;
    __syncthreads();
    for (int id = tid; id < 8 * (LDR / 8); id += NT) {
      const int rho = id / (LDR / 8), a8 = (id % (LDR / 8)) * 8;
      const u16* rp = R + a8 + rho;
      u32x4 o;
      o.x = (unsigned)rp[0] | ((unsigned)rp[1] << 16); o.y = (unsigned)rp[2] | ((unsigned)rp[3] << 16);
      o.z = (unsigned)rp[4] | ((unsigned)rp[5] << 16); o.w = (unsigned)rp[6] | ((unsigned)rp[7] << 16);
      *(u32x4*)(RC + rho * LDR + a8) = o;
    }
    __syncthreads();
    const u16* SRC = order == 0 ? U : Z;
    u16* DST = order == 0 ? Z : U;
    const u16* XG = HT + (size_t)((order + 1) * 256 + ch) * MTOK;
    int tau[TPW], bb[TPW];
    f32x16 acc[TPW];
#pragma unroll
    for (int tw = 0; tw < TPW; ++tw) {
      const int nt = w * TPW + tw, bg = nt % NBG, tg = nt / NBG;
      tau[tw] = 4 * tg + (r >> 3); bb[tw] = 8 * bg + (r & 7);
#pragma unroll
      for (int i = 0; i < 16; ++i) acc[tw][i] = 0.f;
    }
    const int tg_lo = (w * TPW) / NBG, tg_hi = (w * TPW + TPW - 1) / NBG;
    uint2 xpre[TPW][4];
#pragma unroll
    for (int tw = 0; tw < TPW; ++tw) {
      const size_t grow = (size_t)seq_row0(seq0 + bb[tw]);
#pragma unroll
      for (int g4 = 0; g4 < 4; ++g4) xpre[tw][g4] = *(const uint2*)(XG + grow + 32 * tau[tw] + 8 * g4 + 4 * h);
    }
    for (int delta = 4 * tg_lo - (T - 1); delta <= 4 * tg_hi + 3; ++delta) {
      const int x0 = N - 1 - 32 * delta - r + 8 * h;
#pragma unroll
      for (int s2 = 0; s2 < 2; ++s2) {
        const int xx = x0 + 16 * s2;
        const bf16x8 af = *(const bf16x8*)(RC + (xx & 7) * LDR + (xx & ~7));
#pragma unroll
        for (int tw = 0; tw < TPW; ++tw) {
          const int sigma = tau[tw] - delta;
          bf16x8 bf = {0, 0, 0, 0, 0, 0, 0, 0};
          if ((unsigned)sigma < (unsigned)T) bf = *(const bf16x8*)(SRC + bb[tw] * LDU + 8 * h + 32 * sigma + 16 * s2);
          acc[tw] = __builtin_amdgcn_mfma_f32_32x32x16_bf16(af, bf, acc[tw], 0, 0, 0);
        }
      }
    }
#pragma unroll
    for (int tw = 0; tw < TPW; ++tw) {
#pragma unroll
      for (int g4 = 0; g4 < 4; ++g4) {
        const int t = 32 * tau[tw] + 8 * g4 + 4 * h;
        const uint2 sv = *(const uint2*)(SRC + bb[tw] * LDU + t), xv = xpre[tw][g4];
        const float o0 = bflo(xv.x) * (acc[tw][4 * g4 + 0] + bflo(sv.x) * bias[order]);
        const float o1 = bfhi(xv.x) * (acc[tw][4 * g4 + 1] + bfhi(sv.x) * bias[order]);
        const float o2 = bflo(xv.y) * (acc[tw][4 * g4 + 2] + bflo(sv.y) * bias[order]);
        const float o3 = bfhi(xv.y) * (acc[tw][4 * g4 + 3] + bfhi(sv.y) * bias[order]);
        uint2 o; o.x = pack2(o0, o1); o.y = pack2(o2, o3);
        *(uint2*)(DST + bb[tw] * LDU + t) = o;
      }
    }
    __syncthreads();
  }
  for (int id = tid; id < NB * (N / 8); id += NT) {
    const int b = id / (N / 8), q = id % (N / 8);
    *(u32x4*)(HO + (size_t)ch * MTOK + (size_t)seq_row0(seq0 + b) + q * 8) = *(const u32x4*)(U + b * LDU + q * 8);
  }
}

DI void mix_dispatch(CParams& p, int l, int j, char* smem) {
  if (j < 64) { hgrn_item(p, l, 32 + (j >> 3), (j >> 1) & 3, j & 1, smem); return; }
  j -= 64;
  if (j < 256) { mla_item(p, l, 32 + (j >> 5), (j >> 3) & 3, j & 7, smem); return; }
  j -= 256;
  if (j < 256) { diff_item(p, l, 32 + (j >> 5), (j >> 3) & 3, j & 7, smem); return; }
  j -= 256;
  if (j < 256) { hyena_item<2048, 8>(p, l, 32, j, smem); return; }
  j -= 256;
  if (j < 256) { hgrn_item(p, l, j >> 3, (j >> 1) & 3, j & 1, smem); return; }
  j -= 256;
  if (j < 128) { mla_item(p, l, j >> 2, j & 3, 0, smem); return; }
  j -= 128;
  if (j < 128) { diff_item(p, l, j >> 2, j & 3, 0, smem); return; }
  j -= 128;
  hyena_item<256, 32>(p, l, 0, j, smem);
}
constexpr int MIX_ITEMS = 64 + 256 + 256 + 256 + 256 + 128 + 128 + 256;

DI void phase_mix(CParams& p, int l, char* smem) {
  int* slot = (int*)(smem + SLOT_OFF);
  unsigned* ctr = (unsigned*)(p.ws + WS_CTR) + l;
  for (;;) {
    __syncthreads();
    if (TID() == 0) *slot = (int)atomicAdd(ctr, 1u);
    __syncthreads();
    const int j = __builtin_amdgcn_readfirstlane(*slot);
    if (j >= MIX_ITEMS) break;
    mix_dispatch(p, l, j, smem);
  }
}

DI void phase_hcomb(CParams& p, int l) {
  const int lane = TID() & 63;
  const int gw = BID() * NW + (TID() >> 6), nw = gridDim.x * NW;
  const u16* PROJ = (const u16*)(p.ws + WS_ACT);
  const float* OF = (const float*)(p.ws + WS_OF);
  const float* OBW = (const float*)(p.ws + WS_OBW);
  u16* OB = (u16*)(p.ws + WS_HB);
  const float* g = p.in[I_ONORM] + l * 64 + (lane & 15) * 4;
  for (int r = gw; r < MTOK; r += nw) {
    float4 a = *(const float4*)(OF + (size_t)r * 256 + lane * 4);
    float4 b = *(const float4*)(OBW + (size_t)r * 256 + lane * 4);
    float o0 = a.x + b.x, o1 = a.y + b.y, o2 = a.z + b.z, o3 = a.w + b.w;
    float ss = o0 * o0 + o1 * o1 + o2 * o2 + o3 * o3;
    ss += __shfl_xor(ss, 1); ss += __shfl_xor(ss, 2); ss += __shfl_xor(ss, 4); ss += __shfl_xor(ss, 8);
    const float rstd = rsqrtf(ss * (1.f / 64.f) + EPS);
    uint2 raw = *(const uint2*)(PROJ + (size_t)r * INWP + 1024 + lane * 4);
    uint2 o;
    o.x = pack2(o0 * rstd * g[0] * silu_f(bflo(raw.x)), o1 * rstd * g[1] * silu_f(bfhi(raw.x)));
    o.y = pack2(o2 * rstd * g[2] * silu_f(bflo(raw.y)), o3 * rstd * g[3] * silu_f(bfhi(raw.y)));
    *(uint2*)(OB + (size_t)r * 1024 + lane * 4) = o;
  }
}

enum { PH_PRO = 0, PH_FILTNORM, PH_GU0, PH_DN0, PH_GIN, PH_PREP1, PH_GSMALL, PH_PREP2, PH_MIX, PH_HCOMB,
       PH_GOUT, PH_GU1, PH_DN1, PH_COUNT };

DI CParams* launder(CParams* q) { asm volatile("" : "+s"(q)); return q; }

DI void run_phase(CParams* pp, int ph, int l, char* smem) {
  CParams& p = *launder(pp);
  const u16* HB = (const u16*)(p.ws + WS_HB);
  u16* ACT = (u16*)(p.ws + WS_ACT);
  const float* MOD = (const float*)(p.ws + WS_MOD) + (size_t)l * 9 * 9216;
  using namespace pg8;
  GemmJob g0{}, g1{};
  bool is_gemm = false;
  switch (ph) {
    case PH_PRO: if (BID() == 0 && TID() < 64) ((unsigned*)(p.ws + WS_CTR))[TID()] = 0u; phase_wprep(p, smem); phase_mod(p, smem); phase_rope(p); phase_filt(p, smem); break;
    case PH_FILTNORM: phase_filtnorm(p); adaln_rows(p, 0, 0, BID() * NW + (TID() >> 6), gridDim.x * NW, MTOK, true); break;
    case PH_GU0:
    case PH_GU1: {
      const int f = ph == PH_GU1;
      g0 = GemmJob{Gemm{HB, (const u16*)(p.ws + WS_WGU) + (size_t)(l * 2 + f) * 5632 * 1024, MTOK, 5632, 1024},
                   Epi{EPI_GU, ACT, DFF, nullptr, nullptr, 0.f}};
      is_gemm = true;
    } break;
    case PH_DN0:
    case PH_DN1: {
      const int f = ph == PH_DN1;
      g0 = GemmJob{Gemm{ACT, (const u16*)(p.ws + WS_WDN) + (size_t)(l * 2 + f) * 1024 * 2816, MTOK, 1024, 2816},
                   Epi{EPI_RESID, nullptr, 0, p.out, MOD + (f ? 8192 : 2048), 0.5f}};
      is_gemm = true;
    } break;
    case PH_GIN: {
      g0 = GemmJob{Gemm{HB, (const u16*)(p.ws + WS_WIN) + (size_t)l * 3328 * 1024, MTOK, 3328, 1024},
                   Epi{EPI_BF16, ACT, INWP, nullptr, nullptr, 0.f}};
      is_gemm = true;
    } break;
    case PH_GSMALL: {
      g0 = GemmJob{Gemm{(const u16*)(p.ws + WS_CQ), (const u16*)(p.ws + WS_WUQ) + (size_t)l * 512 * 256, MTOK, 512, 256},
                   Epi{EPI_BF16, (u16*)(p.ws + WS_QRAW), 512, nullptr, nullptr, 0.f}};
      g1 = GemmJob{Gemm{(const u16*)(p.ws + WS_CKV), (const u16*)(p.ws + WS_WUKV) + (size_t)l * 512 * 256, NKV, 512, 256},
                   Epi{EPI_BF16, (u16*)(p.ws + WS_KVRAW), 512, nullptr, nullptr, 0.f}};
      is_gemm = true;
    } break;
    case PH_GOUT: {
      g0 = GemmJob{Gemm{HB, (const u16*)(p.ws + WS_WOUT) + (size_t)l * 1024 * 1024, MTOK, 1024, 1024},
                   Epi{EPI_RESID, nullptr, 0, p.out, MOD + 5120, 1.0f}};
      is_gemm = true;
    } break;
    case PH_PREP1: phase_prep1(p, l); phase_hyprep(p, l, smem); break;
    case PH_PREP2: phase_prep2(p, l); phase_vtm(p, smem); break;
    case PH_MIX: phase_mix(p, l, smem); break;
    case PH_HCOMB: phase_hcomb(p, l); phase_hypost(p, smem); break;
    default: break;
  }
  if (is_gemm) {
    int post_l = 0, post_which = 0, post_slot = -1;
    if (ph == PH_DN0) { post_l = l; post_which = 1; post_slot = l * 3 + 0; }
    else if (ph == PH_GOUT) { post_l = l; post_which = 2; post_slot = l * 3 + 1; }
    else if (ph == PH_DN1) { post_l = l + 1; post_which = 0; post_slot = l * 3 + 2; }
    int wjb = 0, wje = 0;
    if (l < 3) {
      if (ph == PH_DN0) { wjb = 0; wje = 2200; }
      else if (ph == PH_GOUT) { wjb = 2200; wje = 3100; }
      else if (ph == PH_DN1) { wjb = 3100; wje = WP_TILES; }
    }
    phase_gemm2(p, g0, g1, smem, post_l, post_which, post_slot, l + 1, wjb, wje);
  }
}

constexpr int SMEM_BYTES = XST_OFF + 64;

#if !MEGA
__global__ void __launch_bounds__(512, 2) k_phase(Params p_unused, int ph, int l) {
  extern __shared__ __attribute__((aligned(16))) char smem[];
  run_phase((CParams*)__builtin_amdgcn_kernarg_segment_ptr(), ph, l, smem);
}
#else
__global__ void __launch_bounds__(512, 2) k_mega(Params p_unused) {
  extern __shared__ __attribute__((aligned(16))) char smem[];
  cg::grid_group grid = cg::this_grid();
  CParams* pp = (CParams*)__builtin_amdgcn_kernarg_segment_ptr();
  volatile LAS unsigned* xst = (volatile LAS unsigned*)(LAS char*)(smem + XST_OFF);
  if (threadIdx.x == 0) { xst[0] = 0u; xst[1] = 0u; }
  __syncthreads();
  XcdBarrier xb = xcd_barrier_post((unsigned*)(pp->ws + WS_BAR), xst);
  for (int step = 0; step < 2 + 4 * (PH_COUNT - PH_GU0); ++step) {
    int ph, l;
    if (step < 2) { ph = step; l = 0; }
    else { const int j = step - 2; l = j / (PH_COUNT - PH_GU0); ph = PH_GU0 + j % (PH_COUNT - PH_GU0); }
    run_phase(pp, ph, l, smem);
    if (step == 0) grid.sync();
    else xcd_barrier(xb);
  }
}
#endif

extern "C" void kernel_launch(void* const* d_in, const int* in_sizes, int n_in, void* d_out, int out_size, void* d_ws,
                              size_t ws_size, hipStream_t stream) {
  Params p{};
  for (int i = 0; i < 33; ++i) p.in[i] = (const float*)d_in[i];
  p.out = (float*)d_out;
  p.ws = (char*)d_ws;
  if (ws_size < WS_END || n_in < 33) {
    fprintf(stderr, "workspace too small: %zu < %zu\n", ws_size, (size_t)WS_END);
    return;
  }
#if MEGA
  static int grid_blocks = 0;
  if (!grid_blocks) {
    int dev = 0, cus = 0, per_cu = 0;
    hipGetDevice(&dev);
    hipDeviceGetAttribute(&cus, hipDeviceAttributeMultiprocessorCount, dev);
    hipFuncSetAttribute((const void*)k_mega, hipFuncAttributeMaxDynamicSharedMemorySize, SMEM_BYTES);
    hipOccupancyMaxActiveBlocksPerMultiprocessor(&per_cu, k_mega, NT, SMEM_BYTES);
    if (per_cu > 1) per_cu = 1;
    grid_blocks = cus * per_cu;
  }
  (void)hipMemsetAsync((char*)d_ws + WS_CTR, 0, 256 + 16384 + 12 * 128 * 4, stream);
  void* args[] = {&p};
  hipError_t e = hipLaunchCooperativeKernel((void*)k_mega, dim3(grid_blocks), dim3(NT), args, SMEM_BYTES, stream);
  if (e != hipSuccess) fprintf(stderr, "cooperative launch failed: %s (grid %d)\n", hipGetErrorString(e), grid_blocks);
#else
  const int G = 256;
  hipFuncSetAttribute((const void*)k_phase, hipFuncAttributeMaxDynamicSharedMemorySize, SMEM_BYTES);
  k_phase<<<G, NT, SMEM_BYTES, stream>>>(p, PH_PRO, 0);
  k_phase<<<G, NT, SMEM_BYTES, stream>>>(p, PH_FILTNORM, 0);
  for (int l = 0; l < 4; ++l)
    for (int ph = PH_GU0; ph < PH_COUNT; ++ph) k_phase<<<G, NT, SMEM_BYTES, stream>>>(p, ph, l);
#endif
}
```
